# Optimizing an MI355X kernel written in HIP

```python
import jax
import jax.numpy as jnp
from jax import lax
import numpy as np


D_MODEL = 2048
BATCH = 4
SEQ = 4096
DEPTH = 2

N_MIXERS = 2
EPS = 1e-6
HG_DK = 128
HG_HEADS = D_MODEL // HG_DK
HG_DV = D_MODEL // HG_HEADS
HG_CHUNK = 64
ATT_HEAD_DIM = 128
ATT_HEADS = D_MODEL // ATT_HEAD_DIM
DIL_BRANCHES = ((128, 1), (512, 4), (2048, 16))
ROPE_THETA = 10000.0
NEG_INF = -1e30
FFN_DENSE = 5504
N_EXPERTS = 8
TOP_K = 2
FFN_EXPERT = 7168
MOE_BLOCK = 512
N_HGRN = (DEPTH + 1) // 2
N_ATTN = DEPTH // 2
N_DENSE = (DEPTH + 1) // 2
N_MOE = DEPTH // 2

kernel_name = 'hybrid_hgrn2_dilated_moe_encoder'


def rms_norm(x, gain):
    xf = x.astype(jnp.float32)
    y = xf * lax.rsqrt(jnp.mean(xf * xf, axis=-1, keepdims=True) + EPS)
    return (y * gain.astype(jnp.float32)).astype(x.dtype)


def rope(t, pos):
    hd = t.shape[-1]
    half = hd // 2
    inv_freq = ROPE_THETA ** (-jnp.arange(half, dtype=jnp.float32) * 2.0 / hd)
    ang = pos[:, None] * inv_freq[None, :]
    cos, sin = jnp.cos(ang), jnp.sin(ang)
    t1, t2 = t[..., :half], t[..., half:]
    return jnp.concatenate([t1 * cos - t2 * sin, t2 * cos + t1 * sin], axis=-1)


def gla_chunk_scan(q, k, v, log_f):
    b, h, l, dk = q.shape
    dv = v.shape[-1]
    c = HG_CHUNK
    n = l // c

    def chunks(t):
        return jnp.moveaxis(t.reshape(b, h, n, c, t.shape[-1]), 2, 0)

    qc, kc, vc = chunks(q), chunks(k), chunks(v)
    g = jnp.cumsum(chunks(log_f), axis=-2)
    incl = jnp.tril(jnp.ones((c, c), dtype=bool))

    def step(state, inp):
        q_i, k_i, v_i, g_i = inp
        o_inter = jnp.einsum('bhtk,bhkv->bhtv', q_i * jnp.exp(g_i), state)
        diff = g_i[:, :, :, None, :] - g_i[:, :, None, :, :]
        decay = jnp.exp(jnp.where(incl[:, :, None], diff, -jnp.inf))
        a = jnp.einsum('bhtk,bhsk,bhtsk->bhts', q_i, k_i, decay)
        o_intra = jnp.einsum('bhts,bhsv->bhtv', a, v_i)
        g_last = g_i[:, :, -1:, :]
        new_state = (jnp.exp(g_last[:, :, 0, :])[..., None] * state
                     + jnp.einsum('bhsk,bhsv->bhkv', k_i * jnp.exp(g_last - g_i), v_i))
        return new_state, o_inter + o_intra

    s0 = jnp.zeros((b, h, dk, dv), jnp.float32)
    _, o = lax.scan(step, s0, (qc, kc, vc, g))
    return jnp.moveaxis(o, 0, 2).reshape(b, h, l, dv)


def hgrn2_mixer(h, w_in, lower_bound, o_gain, w_out):
    b, l, _ = h.shape
    hk = HG_HEADS * HG_DK
    hv = HG_HEADS * HG_DV
    proj = h @ w_in
    q, f_fwd, f_bwd, inp, gate = jnp.split(proj, [hk, 2 * hk, 3 * hk, 3 * hk + hv], axis=-1)

    def heads(t, dh):
        return t.astype(jnp.float32).reshape(b, l, HG_HEADS, dh).transpose(0, 2, 1, 3)

    qh = heads(jax.nn.silu(q.astype(jnp.float32)), HG_DK)
    vh = heads(inp, HG_DV)

    def direction(f_pre, lb):
        f = lb + (1.0 - lb) * jax.nn.sigmoid(f_pre.astype(jnp.float32))
        return heads(1.0 - f, HG_DK), heads(jnp.log(f), HG_DK)

    k_f, lf_f = direction(f_fwd, lower_bound[0])
    k_b, lf_b = direction(f_bwd, lower_bound[1])
    o_f = gla_chunk_scan(qh, k_f, vh, lf_f)
    flip = lambda t: jnp.flip(t, axis=2)
    o_b = flip(gla_chunk_scan(flip(qh), flip(k_b), flip(vh), flip(lf_b)))
    o = (o_f + o_b).transpose(0, 2, 1, 3)
    o = rms_norm(o, o_gain.reshape(HG_HEADS, HG_DV)).reshape(b, l, hv)
    o = o * jax.nn.silu(gate.astype(jnp.float32))
    return o.astype(h.dtype) @ w_out


def dilated_branch(q, k, v, dilation, steps):
    b, h, l, hd = q.shape
    r = dilation
    w = steps
    n = l // r

    def to_res(t):
        return t.reshape(b, h, n, r, hd).transpose(0, 1, 3, 2, 4)

    qr, kr, vr = to_res(q), to_res(k), to_res(v)
    nb = -(-n // w)
    npad = nb * w
    qb = jnp.pad(qr, ((0, 0), (0, 0), (0, 0), (0, npad - n), (0, 0))).reshape(b, h, r, nb, w, hd)

    def windows(t):
        tp = jnp.pad(t, ((0, 0), (0, 0), (0, 0), (w, npad - n + w), (0, 0))).reshape(b, h, r, nb + 2, w, hd)
        return jnp.concatenate([tp[:, :, :, 0:nb], tp[:, :, :, 1:nb + 1], tp[:, :, :, 2:nb + 2]], axis=4)

    kw, vw = windows(kr), windows(vr)
    s = jnp.einsum('bhrnqd,bhrnkd->bhrnqk', qb, kw)
    qq = jnp.arange(w)[:, None]
    kk = jnp.arange(3 * w)[None, :]
    band = (kk >= qq) & (kk <= qq + 2 * w)
    keypos = jnp.arange(nb)[:, None] * w - w + jnp.arange(3 * w)[None, :]
    inrange = (keypos >= 0) & (keypos < n)
    mask = band[None, :, :] & inrange[:, None, :]
    s = jnp.where(mask, s, NEG_INF)
    m = jnp.max(s, axis=-1, keepdims=True)
    p = jnp.exp(s - m)
    den = jnp.sum(p, axis=-1, keepdims=True)
    o = jnp.einsum('bhrnqk,bhrnkd->bhrnqd', p, vw) / den
    lse = (m + jnp.log(den))[..., 0]
    o = o.reshape(b, h, r, npad, hd)[:, :, :, :n].transpose(0, 1, 3, 2, 4).reshape(b, h, l, hd)
    lse = lse.reshape(b, h, r, npad)[:, :, :, :n].transpose(0, 1, 3, 2).reshape(b, h, l)
    return o, lse


def dilated_attention_mixer(h, w_qkv, q_gain, k_gain, w_out):
    b, l, d = h.shape
    proj = h @ w_qkv
    q, k, v = jnp.split(proj, 3, axis=-1)

    def heads(t):
        return t.astype(jnp.float32).reshape(b, l, ATT_HEADS, ATT_HEAD_DIM).transpose(0, 2, 1, 3)

    pos = jnp.arange(l, dtype=jnp.float32)
    qh = rope(rms_norm(heads(q), q_gain), pos) * (ATT_HEAD_DIM ** -0.5)
    kh = rope(rms_norm(heads(k), k_gain), pos)
    vh = heads(v)
    outs, lses = [], []
    for window, dil in DIL_BRANCHES:
        o_br, lse_br = dilated_branch(qh, kh, vh, dil, window // (2 * dil))
        outs.append(o_br)
        lses.append(lse_br)
    wts = jax.nn.softmax(jnp.stack(lses, axis=0), axis=0)
    o = jnp.sum(wts[..., None] * jnp.stack(outs, axis=0), axis=0)
    o = o.transpose(0, 2, 1, 3).reshape(b, l, d)
    return o.astype(h.dtype) @ w_out


def swiglu(h, w_gate, w_up, w_down):
    return (jax.nn.silu(h @ w_gate) * (h @ w_up)) @ w_down


def moe_swiglu(h, w_router, w_gate, w_up, w_down):
    b, l, d = h.shape
    t = b * l
    xf = h.reshape(t, d)
    logits = (xf @ w_router).astype(jnp.float32)
    top_logit, top_e = lax.top_k(logits, TOP_K)
    gates = jax.nn.softmax(top_logit, axis=-1)
    e_flat = top_e.reshape(-1).astype(jnp.int32)
    g_flat = gates.reshape(-1)
    tok_flat = jnp.repeat(jnp.arange(t, dtype=jnp.int32), TOP_K)
    order = jnp.argsort(e_flat, stable=True)
    se, stok, sg = e_flat[order], tok_flat[order], g_flat[order]
    counts = jax.ops.segment_sum(jnp.ones_like(e_flat), e_flat, num_segments=N_EXPERTS)
    padded = (counts + MOE_BLOCK - 1) // MOE_BLOCK * MOE_BLOCK
    pend = jnp.cumsum(padded)
    pstart = pend - padded
    ustart = jnp.cumsum(counts) - counts
    dest = pstart[se] + (jnp.arange(t * TOP_K, dtype=jnp.int32) - ustart[se])
    nblk = -(-(t * TOP_K) // MOE_BLOCK) + N_EXPERTS
    p = nblk * MOE_BLOCK
    slot_tok = jnp.zeros((p,), jnp.int32).at[dest].set(stok)
    slot_gate = jnp.zeros((p,), jnp.float32).at[dest].set(sg)
    blk_start = jnp.arange(nblk, dtype=pend.dtype) * MOE_BLOCK
    blk_e = jnp.minimum(jnp.searchsorted(pend, blk_start, side='right'), N_EXPERTS - 1)

    def expert_block(args):
        e, toks, g = args
        xb = xf[toks]
        y = swiglu(xb, w_gate[e], w_up[e], w_down[e])
        return y * g[:, None].astype(y.dtype)

    y = lax.map(expert_block, (blk_e, slot_tok.reshape(nblk, MOE_BLOCK), slot_gate.reshape(nblk, MOE_BLOCK)))
    out = jnp.zeros((t, d), h.dtype).at[slot_tok].add(y.reshape(p, d).astype(h.dtype))
    return out.reshape(b, l, d)


def setup_inputs(seed: int = 0) -> dict:
    key = jax.random.key(seed)
    ks = jax.random.split(key, 18)
    f32 = jnp.float32
    hk = HG_HEADS * HG_DK
    hv = HG_HEADS * HG_DV

    def nrm(k, shape, fan_in):
        return jax.random.normal(k, shape, f32) * (fan_in ** -0.5)

    def gain(k, shape):
        return 1.0 + 0.02 * jax.random.normal(k, shape, f32)

    return {
        'x': jax.random.normal(ks[0], (BATCH, SEQ, D_MODEL), f32),
        'norm_gains': gain(ks[1], (DEPTH, 2, D_MODEL)),
        'hgrn_w_in': nrm(ks[2], (N_HGRN, D_MODEL, 3 * hk + 2 * hv), D_MODEL),
        'hgrn_lb_logits': 0.5 * jax.random.normal(ks[3], (DEPTH + 1, 2, hk), f32),
        'hgrn_onorm': gain(ks[4], (N_HGRN, hv)),
        'hgrn_w_out': nrm(ks[5], (N_HGRN, hv, D_MODEL), hv),
        'attn_w_qkv': nrm(ks[6], (N_ATTN, D_MODEL, 3 * D_MODEL), D_MODEL),
        'attn_q_gain': gain(ks[7], (N_ATTN, ATT_HEAD_DIM)),
        'attn_k_gain': gain(ks[8], (N_ATTN, ATT_HEAD_DIM)),
        'attn_w_out': nrm(ks[9], (N_ATTN, D_MODEL, D_MODEL), D_MODEL),
        'ffn_w_gate': nrm(ks[10], (N_DENSE, D_MODEL, FFN_DENSE), D_MODEL),
        'ffn_w_up': nrm(ks[11], (N_DENSE, D_MODEL, FFN_DENSE), D_MODEL),
        'ffn_w_down': nrm(ks[12], (N_DENSE, FFN_DENSE, D_MODEL), FFN_DENSE),
        'moe_w_router': nrm(ks[13], (N_MOE, D_MODEL, N_EXPERTS), D_MODEL),
        'moe_w_gate': nrm(ks[14], (N_MOE, N_EXPERTS, D_MODEL, FFN_EXPERT), D_MODEL),
        'moe_w_up': nrm(ks[15], (N_MOE, N_EXPERTS, D_MODEL, FFN_EXPERT), D_MODEL),
        'moe_w_down': nrm(ks[16], (N_MOE, N_EXPERTS, FFN_EXPERT, D_MODEL), FFN_EXPERT),
    }


def reference(x, norm_gains, hgrn_w_in, hgrn_lb_logits, hgrn_onorm, hgrn_w_out,
              attn_w_qkv, attn_q_gain, attn_k_gain, attn_w_out,
              ffn_w_gate, ffn_w_up, ffn_w_down,
              moe_w_router, moe_w_gate, moe_w_up, moe_w_down):
    lb_all = jnp.cumsum(jax.nn.softmax(hgrn_lb_logits.astype(jnp.float32), axis=0), axis=0)
    for i in range(DEPTH):
        j = i // N_MIXERS
        hn = rms_norm(x, norm_gains[i, 0])
        if i % N_MIXERS == 0:
            mix = hgrn2_mixer(hn, hgrn_w_in[j], lb_all[i], hgrn_onorm[j], hgrn_w_out[j])
        else:
            mix = dilated_attention_mixer(hn, attn_w_qkv[j], attn_q_gain[j], attn_k_gain[j], attn_w_out[j])
        x = x + mix.astype(x.dtype)
        hn = rms_norm(x, norm_gains[i, 1])
        jf = i // 2
        if i % 2 == 0:
            ff = swiglu(hn, ffn_w_gate[jf], ffn_w_up[jf], ffn_w_down[jf])
        else:
            ff = moe_swiglu(hn, moe_w_router[jf], moe_w_gate[jf], moe_w_up[jf], moe_w_down[jf])
        x = x + ff.astype(x.dtype)
    return x
```

```cpp
#include <hip/hip_runtime.h>
#include <cstdio>
#include <cstdint>

namespace pg8 {
#define PG8_LAS __attribute__((address_space(3)))
typedef unsigned short bf16_t;
typedef short bf16x8 __attribute__((ext_vector_type(8)));
typedef float f32x4 __attribute__((ext_vector_type(4)));
typedef unsigned u32x4 __attribute__((ext_vector_type(4)));
constexpr int BM = 256, BK = 64, HALF = 128, HTB = HALF * BK * 2  , STAGE_BYTES = 8 * HTB, NXCD = 8, WGM = 8;

__host__ __device__ __forceinline__ int lds_byte(int r, int c) { const int st = (r >> 4) * 2 + (c >> 5), rr = r & 15, cc = c & 31, ob = rr * 64 + cc * 2; return st * 1024 + (ob ^ (((ob >> 9) & 1) << 5)); }
__host__ __device__ __forceinline__ void stage_rc(int b, int& R, int& C) { const int st = b / 1024, sb = b % 1024, swz = sb ^ (((sb >> 9) & 1) << 5); R = (st >> 1) * 16 + swz / 64; C = (st & 1) * 32 + (swz % 64) / 2; }
__host__ __device__ __forceinline__ int perm32(int rho) { const int n = rho >> 4, i = rho & 15; return 8 * (i >> 2) + 4 * n + (i & 3); }

struct Unit { int pm, pn; };
struct Gemm { const bf16_t* A; const bf16_t* Bt; int K; };

struct StaticOrder {
    int nM, nN, nwg, G, c;
    __host__ __device__ void init(int nM_, int nN_, int G_, int c_) { nM = nM_; nN = nN_; nwg = nM * nN; G = G_; c = c_; }
    __host__ __device__ bool next(int i, Unit& u) const {
        const long L = (long)i * G + c; if (L >= nwg) return false;
        int wgid = (int)L; { const int q = nwg / NXCD, r = nwg % NXCD, xcd = wgid % NXCD, off = wgid / NXCD; wgid = (xcd < r ? xcd * (q + 1) : r * (q + 1) + (xcd - r) * q) + off; }
        const int nig = WGM * nN, gid = wgid / nig, fm = gid * WGM, gsz = (nM - fm) < WGM ? (nM - fm) : WGM;
        u.pm = fm + ((wgid % nig) % gsz); u.pn = (wgid % nig) / gsz; return true;
    }
    __device__ __forceinline__ const char* a_ptr(const Gemm& g, const Unit& u, size_t tstep) const { return (const char*)g.A + (size_t)u.pm * tstep; }
    __device__ __forceinline__ const char* b_ptr(const Gemm& g, const Unit& u, size_t tstep) const { return (const char*)g.Bt + (size_t)u.pn * tstep; }
    __device__ __forceinline__ void a_ready(const Unit&) const {}
    __device__ __forceinline__ void done(const Unit&) const {}
};
struct MoeOrder : StaticOrder {
    int c1, c2, c3, c4, c5, c6, c7; size_t estride;
    __device__ __forceinline__ int expert(int pm) const { return (pm >= c1) + (pm >= c2) + (pm >= c3) + (pm >= c4) + (pm >= c5) + (pm >= c6) + (pm >= c7); }
    __device__ __forceinline__ const char* b_ptr(const Gemm& g, const Unit& u, size_t tstep) const { return (const char*)g.Bt + (size_t)expert(u.pm) * estride + (size_t)u.pn * tstep; }
};

__device__ __forceinline__ unsigned cvt_pk_bf16(float lo, float hi) { unsigned r; asm volatile("v_cvt_pk_bf16_f32 %0, %1, %2" : "=v"(r) : "v"(lo), "v"(hi)); return r; }
__device__ __forceinline__ float silu_f(float x) { return x * __builtin_amdgcn_rcpf(1.0f + __expf(-x)); }

struct EpiBf16 {
    static constexpr bool PERM = true, AFTER_DRAIN = false;
    bf16_t* O; int ldc;
    __device__ __forceinline__ void operator()(const f32x4 (&acc)[2][2][4][2], const Unit& u, int wr, int wc, int fr, int fq) const {
        const int row0 = u.pm * BM + wr * 64 + fr, col0 = u.pn * BM + wc * 32 + 8 * fq;
#pragma unroll
        for (int ai = 0; ai < 2; ++ai)
#pragma unroll
            for (int m = 0; m < 4; ++m) { bf16_t* rowp = O + (size_t)(row0 + ai * HALF + m * 16) * ldc + col0;
#pragma unroll
                for (int bj = 0; bj < 2; ++bj) { const f32x4 v0 = acc[ai][bj][m][0], v1 = acc[ai][bj][m][1];
                    u32x4 w; w.x = cvt_pk_bf16(v0[0], v0[1]); w.y = cvt_pk_bf16(v0[2], v0[3]); w.z = cvt_pk_bf16(v1[0], v1[1]); w.w = cvt_pk_bf16(v1[2], v1[3]);
                    *(u32x4*)(rowp + bj * HALF) = w; } }
    }
};
struct EpiSwiglu {
    static constexpr bool PERM = true, AFTER_DRAIN = false;
    bf16_t* O; int ldc;
    __device__ __forceinline__ void operator()(const f32x4 (&acc)[2][2][4][2], const Unit& u, int wr, int wc, int fr, int fq) const {
        const int row0 = u.pm * BM + wr * 64 + fr, col0 = u.pn * HALF + wc * 32 + 8 * fq;
#pragma unroll
        for (int ai = 0; ai < 2; ++ai)
#pragma unroll
            for (int m = 0; m < 4; ++m) { bf16_t* rowp = O + (size_t)(row0 + ai * HALF + m * 16) * ldc + col0;
                const f32x4 g0 = acc[ai][0][m][0], g1 = acc[ai][0][m][1], u0 = acc[ai][1][m][0], u1 = acc[ai][1][m][1];
                float h[8];
#pragma unroll
                for (int j = 0; j < 4; ++j) { h[j] = silu_f(g0[j]) * u0[j]; h[4 + j] = silu_f(g1[j]) * u1[j]; }
                u32x4 w; w.x = cvt_pk_bf16(h[0], h[1]); w.y = cvt_pk_bf16(h[2], h[3]); w.z = cvt_pk_bf16(h[4], h[5]); w.w = cvt_pk_bf16(h[6], h[7]);
                *(u32x4*)rowp = w; }
    }
};
struct EpiResF32 {
    static constexpr bool PERM = false, AFTER_DRAIN = false;
    const float* base; float* out; int ldc;
    __device__ __forceinline__ void operator()(const f32x4 (&acc)[2][2][4][2], const Unit& u, int wr, int wc, int fr, int fq) const {
        const int row0 = u.pm * BM + wr * 64 + fr, col0 = u.pn * BM + wc * 32 + 4 * fq;
#pragma unroll
        for (int ai = 0; ai < 2; ++ai)
#pragma unroll
            for (int m = 0; m < 4; ++m) { const size_t off = (size_t)(row0 + ai * HALF + m * 16) * ldc + col0;
#pragma unroll
                for (int bj = 0; bj < 2; ++bj)
#pragma unroll
                    for (int n = 0; n < 2; ++n) { const f32x4 bs = *(const f32x4*)(base + off + bj * HALF + n * 16); *(f32x4*)(out + off + bj * HALF + n * 16) = bs + acc[ai][bj][m][n]; }
                asm volatile("" ::: "memory"); }
    }
};

template <class Epi, class Sched, bool ALIGN_EPI = false, bool SP2 = false>
__device__ __forceinline__ void gemm_phase(PG8_LAS unsigned char* lds, const Gemm g, const Sched& S, const Epi& E) {
    const int tid = threadIdx.x, wid = __builtin_amdgcn_readfirstlane(tid >> 6), lane = tid & 63, wr = wid >> 2, wc = wid & 3, fr = lane & 15, fq = lane >> 4;
    const int K = g.K, nt = K / BK;
    unsigned voffA[2], voffB[2];
#pragma unroll
    for (int i = 0; i < 2; ++i) { int R, C; stage_rc(tid * 16 + i * 8192, R, C); const int Rb = Epi::PERM ? ((R & ~31) + perm32(R & 31)) : R;
        voffA[i] = (unsigned)(R * K + C) * 2u; voffB[i] = (unsigned)(Rb * K + C) * 2u; }
    const size_t kstep = (size_t)(BK * 2);
    const size_t hstep = (size_t)HALF * K * 2;
    const size_t tstep = 2 * hstep;
    const unsigned ldsw = (unsigned)wid * 1024u;
    const int aoff = lds_byte(wr * 64 + fr, fq * 8), boff = lds_byte(wc * 32 + fr, fq * 8);
#define PG8_SA(b, h) (((b) * 2 + (h)) * HTB)
#define PG8_SB(b, h) ((4 + (b) * 2 + (h)) * HTB)
#define PG8_STAGE(bufoff, gbase, voff) do { _Pragma("unroll") for (int _i = 0; _i < 2; ++_i) \
        __builtin_amdgcn_global_load_lds((const unsigned*)((const char*)(gbase) + (voff)[_i]), (PG8_LAS unsigned*)(lds + (bufoff) + ldsw + _i * 8192), 16, 0, 0); } while (0)
#define PG8_LDA(dst, b, h) do { _Pragma("unroll") for (int m = 0; m < 4; ++m) _Pragma("unroll") for (int k = 0; k < 2; ++k) dst[m][k] = *(const PG8_LAS bf16x8*)(lds + PG8_SA(b, h) + aoff + m * 2048 + k * 1024); } while (0)
#define PG8_LDB(dst, b, h) do { _Pragma("unroll") for (int n = 0; n < 2; ++n) _Pragma("unroll") for (int k = 0; k < 2; ++k) dst[n][k] = *(const PG8_LAS bf16x8*)(lds + PG8_SB(b, h) + boff + n * 2048 + k * 1024); } while (0)
#define PG8_MMA(ai, bj, At, Bt) do { __builtin_amdgcn_s_setprio(1); _Pragma("unroll") for (int m = 0; m < 4; ++m) _Pragma("unroll") for (int n = 0; n < 2; ++n) _Pragma("unroll") for (int k = 0; k < 2; ++k) \
        acc[ai][bj][m][n] = __builtin_amdgcn_mfma_f32_16x16x32_bf16(Bt[n][k], At[m][k], acc[ai][bj][m][n], 0, 0, 0); __builtin_amdgcn_s_setprio(0); } while (0)
#define PG8_WAIT_V(n) asm volatile("s_waitcnt vmcnt(" #n ")" ::: "memory")
#define PG8_WAIT_L(n) asm volatile("s_waitcnt lgkmcnt(" #n ")" ::: "memory")
#define PG8_BAR __builtin_amdgcn_s_barrier()
#define PG8_SCHED __builtin_amdgcn_sched_barrier(0)
    Unit cur, nxt; int ui = 0;
    if (!S.next(0, cur)) return;
    f32x4 acc[2][2][4][2];
#pragma unroll
    for (int a = 0; a < 2; ++a)
#pragma unroll
        for (int b = 0; b < 2; ++b)
#pragma unroll
            for (int m = 0; m < 4; ++m)
#pragma unroll
                for (int n = 0; n < 2; ++n) acc[a][b][m][n] = (f32x4){0.f, 0.f, 0.f, 0.f};
    bf16x8 At[4][2], B0[2][2], B1[2][2];
    const char* cA = S.a_ptr(g, cur, tstep); const char* cB = S.b_ptr(g, cur, tstep);
    S.a_ready(cur);
    if constexpr (SP2) {
        PG8_STAGE(PG8_SB(0, 0), cB, voffB); PG8_STAGE(PG8_SB(0, 1), cB + hstep, voffB); PG8_STAGE(PG8_SA(0, 0), cA, voffA); PG8_STAGE(PG8_SA(0, 1), cA + hstep, voffA);
        if (wr == 1) PG8_BAR;
        PG8_WAIT_V(2); PG8_BAR;
        PG8_STAGE(PG8_SB(1, 0), cB + kstep, voffB); PG8_STAGE(PG8_SA(1, 0), cA + kstep, voffA); PG8_STAGE(PG8_SB(1, 1), cB + hstep + kstep, voffB);
        PG8_WAIT_V(6); PG8_BAR;
    } else {
        PG8_STAGE(PG8_SB(0, 0), cB, voffB); PG8_STAGE(PG8_SA(0, 0), cA, voffA); PG8_STAGE(PG8_SB(0, 1), cB + hstep, voffB); PG8_STAGE(PG8_SA(0, 1), cA + hstep, voffA);
        if (wr == 1) PG8_BAR;
        PG8_WAIT_V(4); PG8_BAR;
        PG8_STAGE(PG8_SB(1, 0), cB + kstep, voffB); PG8_STAGE(PG8_SA(1, 0), cA + kstep, voffA); PG8_STAGE(PG8_SB(1, 1), cB + hstep + kstep, voffB);
        PG8_WAIT_V(6); PG8_BAR;
    }
    for (;;) {
        const bool has_next = S.next(ui + 1, nxt);
        const char* nA = has_next ? S.a_ptr(g, nxt, tstep) : cA; const char* nB = has_next ? S.b_ptr(g, nxt, tstep) : cB;
        for (int t = 0; t < nt; t += 2) {
            const bool last = (t == nt - 2);
            const char* a1 = cA + (size_t)(t + 1) * kstep;
            const char* a2 = last ? nA : cA + (size_t)(t + 2) * kstep; const char* b2 = last ? nB : cB + (size_t)(t + 2) * kstep;
            const char* a3 = a2 + kstep; const char* b3 = b2 + kstep;
            if (last && has_next) S.a_ready(nxt);
            if constexpr (SP2) {
            PG8_LDB(B0, 0, 0); PG8_LDB(B1, 0, 1); PG8_SCHED; PG8_LDA(At, 0, 0); PG8_STAGE(PG8_SA(1, 1), a1 + hstep, voffA);
            PG8_WAIT_V(8); PG8_WAIT_L(0); PG8_BAR; PG8_MMA(0, 0, At, B0); PG8_MMA(0, 1, At, B1); PG8_BAR; PG8_SCHED;
            PG8_LDA(At, 0, 1); PG8_STAGE(PG8_SB(0, 0), b2, voffB); PG8_STAGE(PG8_SB(0, 1), b2 + hstep, voffB); PG8_STAGE(PG8_SA(0, 0), a2, voffA);
            PG8_WAIT_V(8); PG8_WAIT_L(0); PG8_BAR; PG8_MMA(1, 0, At, B0); PG8_MMA(1, 1, At, B1); PG8_BAR; PG8_SCHED;
            PG8_LDB(B0, 1, 0); PG8_LDB(B1, 1, 1); PG8_SCHED; PG8_LDA(At, 1, 0); PG8_STAGE(PG8_SA(0, 1), a2 + hstep, voffA);
            PG8_WAIT_V(8); PG8_WAIT_L(0); PG8_BAR; PG8_MMA(0, 0, At, B0); PG8_MMA(0, 1, At, B1); PG8_BAR; PG8_SCHED;
            PG8_LDA(At, 1, 1); PG8_STAGE(PG8_SB(1, 0), b3, voffB); PG8_STAGE(PG8_SB(1, 1), b3 + hstep, voffB); PG8_STAGE(PG8_SA(1, 0), a3, voffA);
            PG8_WAIT_V(8); PG8_WAIT_L(0); PG8_BAR; PG8_MMA(1, 0, At, B0); PG8_MMA(1, 1, At, B1); PG8_BAR; PG8_SCHED;
            } else {
            PG8_LDB(B0, 0, 0); PG8_SCHED; PG8_LDA(At, 0, 0); PG8_STAGE(PG8_SA(1, 1), a1 + hstep, voffA);
            PG8_WAIT_L(8); PG8_BAR; PG8_WAIT_L(0); PG8_MMA(0, 0, At, B0); PG8_BAR; PG8_SCHED;
            PG8_LDB(B1, 0, 1); PG8_STAGE(PG8_SB(0, 0), b2, voffB);
            PG8_BAR; PG8_WAIT_L(0); PG8_MMA(0, 1, At, B1); PG8_BAR;
            PG8_LDA(At, 0, 1); PG8_STAGE(PG8_SA(0, 0), a2, voffA);
            PG8_BAR; PG8_WAIT_L(0); PG8_MMA(1, 0, At, B0); PG8_BAR; PG8_SCHED;
            PG8_STAGE(PG8_SB(0, 1), b2 + hstep, voffB);
            PG8_WAIT_V(6); PG8_BAR; PG8_MMA(1, 1, At, B1); PG8_BAR;
            PG8_LDB(B0, 1, 0); PG8_SCHED; PG8_LDA(At, 1, 0); PG8_STAGE(PG8_SA(0, 1), a2 + hstep, voffA);
            PG8_WAIT_L(8); PG8_BAR; PG8_WAIT_L(0); PG8_MMA(0, 0, At, B0); PG8_BAR; PG8_SCHED;
            PG8_LDB(B1, 1, 1); PG8_STAGE(PG8_SB(1, 0), b3, voffB);
            PG8_BAR; PG8_WAIT_L(0); PG8_MMA(0, 1, At, B1); PG8_BAR;
            PG8_LDA(At, 1, 1); PG8_STAGE(PG8_SA(1, 0), a3, voffA);
            PG8_BAR; PG8_WAIT_L(0); PG8_MMA(1, 0, At, B0); PG8_BAR; PG8_SCHED;
            PG8_STAGE(PG8_SB(1, 1), b3 + hstep, voffB);
            PG8_WAIT_V(6); PG8_BAR; PG8_MMA(1, 1, At, B1); PG8_BAR;
            }
        }
        if constexpr (ALIGN_EPI) { if (wr == 0) PG8_BAR; }
        if constexpr (!Epi::AFTER_DRAIN) { E(acc, cur, wr, wc, fr, fq); S.done(cur); }
        if (!has_next) break;
#pragma unroll
        for (int a = 0; a < 2; ++a)
#pragma unroll
            for (int b = 0; b < 2; ++b)
#pragma unroll
                for (int m = 0; m < 4; ++m)
#pragma unroll
                    for (int n = 0; n < 2; ++n) acc[a][b][m][n] = (f32x4){0.f, 0.f, 0.f, 0.f};
        cur = nxt; cA = nA; cB = nB; ++ui;
        if constexpr (ALIGN_EPI) { if (wr == 1) PG8_BAR; }
    }
    PG8_WAIT_V(0);
    if constexpr (!ALIGN_EPI) { if (wr == 0) PG8_BAR; }
    PG8_BAR;
    if constexpr (Epi::AFTER_DRAIN) { E.fused(acc, cur, wr, wc, fr, fq, lds, wid, lane); S.done(cur); }
#undef PG8_SA
#undef PG8_SB
#undef PG8_STAGE
#undef PG8_LDA
#undef PG8_LDB
#undef PG8_MMA
#undef PG8_WAIT_V
#undef PG8_WAIT_L
#undef PG8_BAR
#undef PG8_SCHED
}
}

constexpr int T = 16384, D = 2048, SEQ = 4096, NBATCH = 4, NH = 16, HD = 128;
constexpr int N_IN = 10240, FFN = 5504, NGU = 2 * FFN, NQKV = 3 * D, NE = 8, FE = 7168, NMGU = 2 * FE;
constexpr int P_MAX = 2 * T + NE * 256;
constexpr float EPS = 1e-6f;
constexpr int NWAVES = 8, NTHREADS = 512;

constexpr size_t MiB = 1u << 20;
constexpr size_t WS_CTL = 0, CTL_ZERO_BYTES = 1 * MiB;
constexpr size_t WS_W_IN  = 1 * MiB;
constexpr size_t WS_W_HO  = WS_W_IN  + (size_t)N_IN * D * 2;
constexpr size_t WS_W_GU  = WS_W_HO  + (size_t)D * D * 2;
constexpr size_t WS_W_DN  = WS_W_GU  + (size_t)NGU * D * 2;
constexpr size_t WS_W_QKV = WS_W_DN  + (size_t)D * FFN * 2;
constexpr size_t WS_W_AO  = WS_W_QKV + (size_t)NQKV * D * 2;
constexpr size_t WS_W_MGU = WS_W_AO  + (size_t)D * D * 2;
constexpr size_t WS_W_MDN = WS_W_MGU + (size_t)NE * NMGU * D * 2;
constexpr size_t WS_ARENA = WS_W_MDN + (size_t)NE * D * FE * 2;
constexpr size_t A_HN   = WS_ARENA;
constexpr size_t A_BIG  = A_HN + (size_t)T * D * 2;
constexpr size_t A_OF   = A_BIG + (size_t)T * N_IN * 2;
constexpr size_t A_LSE  = A_OF + (size_t)3 * T * D * 2;
constexpr size_t A_OB   = A_LSE + (size_t)3 * T * NH * 4;
constexpr size_t A_XG   = A_BIG;
constexpr size_t A_MH   = A_XG + (size_t)P_MAX * D * 2;
constexpr size_t A_REC  = (A_MH + (size_t)P_MAX * FE * 2 > A_OB + (size_t)T * D * 2) ? A_MH + (size_t)P_MAX * FE * 2 : A_OB + (size_t)T * D * 2;
constexpr size_t A_TSLOT = A_REC + (size_t)T * 32;
constexpr size_t WS_END = A_TSLOT + (size_t)T * 8;
static_assert(WS_END < (size_t)1750 * MiB, "workspace map too large");
constexpr int CW_BAR = 4096;
constexpr int CW_MOE = 2048;
constexpr int N_PHASES = 19;

constexpr int RING_BYTES = 131072;
constexpr int MISC_OFF = RING_BYTES;
constexpr int LDS_BYTES = 147456;

#define GAS __attribute__((address_space(1)))
#define LAS __attribute__((address_space(3)))
typedef unsigned short bf16;
typedef unsigned v4u __attribute__((ext_vector_type(4)));
typedef unsigned v2u __attribute__((ext_vector_type(2)));
typedef float f32x4 __attribute__((ext_vector_type(4)));
typedef short bf16x8 __attribute__((ext_vector_type(8)));
#define RLX_AGENT __ATOMIC_RELAXED, __HIP_MEMORY_SCOPE_AGENT
#define LDS_WAIT() asm volatile("s_waitcnt lgkmcnt(0)" ::: "memory")
__device__ __forceinline__ unsigned f2bf(float f) { unsigned u = __builtin_bit_cast(unsigned, f); return (u + 0x7fffu + ((u >> 16) & 1u)) >> 16; }
__device__ __forceinline__ unsigned pk2(float lo, float hi) { return f2bf(lo) | (f2bf(hi) << 16); }
__device__ __forceinline__ float bflo(unsigned w) { return __builtin_bit_cast(float, w << 16); }
__device__ __forceinline__ float bfhi(unsigned w) { return __builtin_bit_cast(float, w & 0xffff0000u); }
__device__ __forceinline__ float bf2f(bf16 h) { return __builtin_bit_cast(float, (unsigned)h << 16); }

#define XB_TMO      128
#define XB_XCNT(j)  (256  + 64 * (j))
#define XB_XSUB(j)  (1280 + 64 * (j))
#define XB_XGEN(j)  (2304 + 64 * (j))
#define XB_TOP      3328
#define XB_TOPGEN   3392
#define XCD_BAR_WORDS 3456
#define XB_SPIN_CAP (1u << 18)
__device__ __forceinline__ unsigned xb_ld(unsigned* p)              { return __hip_atomic_load(p, __ATOMIC_RELAXED, __HIP_MEMORY_SCOPE_AGENT); }
__device__ __forceinline__ unsigned xb_add(unsigned* p, unsigned v) { return __hip_atomic_fetch_add(p, v, __ATOMIC_RELAXED, __HIP_MEMORY_SCOPE_AGENT); }
__device__ __forceinline__ unsigned xb_xcc_id() { return (unsigned)__builtin_amdgcn_s_getreg((3 << 11) | 20) & 0xFu; }
#define XB_SPIN(cond, bar) do { unsigned _sp = 0; while (cond) { __builtin_amdgcn_s_sleep(1); \
    if ((++_sp & 255u) == 0u) { if (xb_ld(&(bar)[XB_TMO])) break; if (_sp > XB_SPIN_CAP) { atomicAdd(&(bar)[XB_TMO], 1u); break; } } } } while (0)
struct XcdBarrier { unsigned* bar; unsigned x; volatile LAS unsigned* st; };
__device__ __forceinline__ XcdBarrier xcd_barrier_post(unsigned* bar, volatile LAS unsigned* st) {
    XcdBarrier b; b.bar = bar; b.x = xb_xcc_id(); b.st = st;
    if (threadIdx.x == 0) (void)xb_add(&bar[XB_XCNT(b.x)], 1u);
    return b;
}
__device__ __forceinline__ void xcd_barrier_complete(unsigned* bar, unsigned x, unsigned& nloc, unsigned& nx) {
    const unsigned G = gridDim.x * gridDim.y * gridDim.z;
    unsigned sum, cnt, mine, sp = 0u;
    for (;;) {
        sum = 0u; cnt = 0u; mine = 0u;
#pragma unroll
        for (unsigned j = 0; j < 16; ++j) { const unsigned c = xb_ld(&bar[XB_XCNT(j)]); sum += c; cnt += (c > 0u) ? 1u : 0u; mine = (j == x) ? c : mine; }
        if (sum == G) break;
        __builtin_amdgcn_s_sleep(1);
        if ((++sp & 255u) == 0u) { if (xb_ld(&bar[XB_TMO])) break; if (sp > XB_SPIN_CAP) { atomicAdd(&bar[XB_TMO], 1u); break; } }
    }
    nloc = mine > 0u ? mine : 1u; nx = cnt > 0u ? cnt : 1u;
}
__device__ __forceinline__ void xcd_barrier(const XcdBarrier& b) {
    asm volatile("s_waitcnt vmcnt(0)" ::: "memory");
    __syncthreads();
    if (threadIdx.x == 0) {
        unsigned* bar = b.bar;
        __builtin_amdgcn_s_waitcnt(0);
        unsigned nloc = b.st[0], nx = b.st[1];
        if (nloc == 0u) { xcd_barrier_complete(bar, b.x, nloc, nx); b.st[0] = nloc; b.st[1] = nx; }
        const unsigned old = xb_add(&bar[XB_XSUB(b.x)], 1u);
        const unsigned gen = old / nloc;
        if (old + 1u == (gen + 1u) * nloc) {
            __builtin_amdgcn_fence(__ATOMIC_RELEASE, "agent");
            asm volatile("s_waitcnt vmcnt(0)" ::: "memory");
            const unsigned og = xb_add(&bar[XB_TOP], 1u);
            const unsigned tg = og / nx;
            if (og + 1u == (tg + 1u) * nx) xb_add(&bar[XB_TOPGEN], 1u);
            else XB_SPIN(xb_ld(&bar[XB_TOPGEN]) == tg, bar);
            __builtin_amdgcn_fence(__ATOMIC_ACQUIRE, "agent");
            xb_add(&bar[XB_XGEN(b.x)], 1u);
            asm volatile("s_waitcnt vmcnt(0)" ::: "memory");
        } else {
            XB_SPIN(xb_ld(&bar[XB_XGEN(b.x)]) == gen, bar);
            __builtin_amdgcn_fence(__ATOMIC_ACQUIRE, "agent");
            asm volatile("s_waitcnt vmcnt(0)" ::: "memory");
        }
    }
    __syncthreads();
}

struct Frame {
    LAS unsigned char* lds;
    unsigned* ctl;
    int tid, lane, wave, vcu, G;
    const float *x, *gains, *w_in, *lbl, *onorm, *w_ho, *w_qkv, *qgain, *kgain, *w_ao, *w_g, *w_u, *w_d, *w_r, *mw_g, *mw_u, *mw_d;
    float* out;
    bf16 *Wt_in, *Wt_ho, *Wt_gu, *Wt_dn, *Wt_qkv, *Wt_ao, *Wt_mgu, *Wt_mdn;
    bf16 *hn, *big, *of, *ob, *xg, *mh;
    float* lse; int* rec; int* tslot;
};
__device__ __forceinline__ float wave_sum(float v) {
#pragma unroll
    for (int o = 1; o < 64; o <<= 1) v += __shfl_xor(v, o);
    return v;
}

__device__ __forceinline__ void p0_transpose_item(const float* W, int K, int N, bf16* WT, LAS float* scr, int item, int lane, int mode) {
    const int nblk = N / 32, kb = item / nblk, nb = item % nblk, k0 = 64 * kb, n0 = 32 * nb;
    const int orow0 = mode == 0 ? n0 : (((n0 >> 7) << 8) + (mode == 2 ? 128 : 0) + (n0 & 127));
#pragma unroll 8
    for (int i = 0; i < 32; ++i) { const int kk = 2 * i + (lane >> 5); scr[kk * 33 + (lane & 31)] = W[(size_t)(k0 + kk) * N + n0 + (lane & 31)]; }
    LDS_WAIT(); asm volatile("" ::: "memory");
    const int c = lane & 7;
#pragma unroll
    for (int j = 0; j < 4; ++j) { const int n = (lane >> 3) + 8 * j; const LAS float* s = scr + (8 * c) * 33 + n;
        v4u o; o.x = pk2(s[0 * 33], s[1 * 33]); o.y = pk2(s[2 * 33], s[3 * 33]); o.z = pk2(s[4 * 33], s[5 * 33]); o.w = pk2(s[6 * 33], s[7 * 33]);
        *(GAS v4u*)(WT + (size_t)(orow0 + n) * K + k0 + 8 * c) = o; }
    LDS_WAIT(); asm volatile("" ::: "memory");
}
__device__ __forceinline__ void rms_row_to_bf16(const float* xrow, const float* gain, bf16* orow, int lane) {
    const GAS f32x4* xr = (const GAS f32x4*)xrow + lane; const GAS f32x4* gr = (const GAS f32x4*)gain + lane;
    f32x4 v[8]; float s = 0.f;
#pragma unroll
    for (int j = 0; j < 8; ++j) { v[j] = xr[64 * j]; s += (v[j].x * v[j].x + v[j].y * v[j].y) + (v[j].z * v[j].z + v[j].w * v[j].w); }
    const float r = 1.0f / sqrtf(wave_sum(s) * (1.f / D) + EPS);
    GAS v2u* o8 = (GAS v2u*)orow + lane;
#pragma unroll
    for (int j = 0; j < 8; ++j) { const f32x4 g = gr[64 * j]; v2u w; w.x = pk2(v[j].x * r * g.x, v[j].y * r * g.y); w.y = pk2(v[j].z * r * g.z, v[j].w * r * g.w); o8[64 * j] = w; }
}
__device__ __forceinline__ void rms_phase(Frame& F, const float* x, const float* gain, bf16* hn) {
    const int gw = F.vcu * NWAVES + F.wave, NGW = F.G * NWAVES;
    for (int m = gw; m < T; m += NGW) rms_row_to_bf16(x + (size_t)m * D, gain, hn + (size_t)m * D, F.lane);
}
__device__ __forceinline__ void p0_prologue(Frame& F) {
    LAS float* scr = (LAS float*)(F.lds + F.wave * 16384);
    const int gw = F.vcu * NWAVES + F.wave, NGW = F.G * NWAVES;
    constexpr int I_IN = (D / 64) * (N_IN / 32), I_SQ = (D / 64) * (D / 32), I_G = (D / 64) * (FFN / 32), I_DN = (FFN / 64) * (D / 32), I_QKV = (D / 64) * (NQKV / 32);
    constexpr int I_MG = (D / 64) * (FE / 32), I_MD = (FE / 64) * (D / 32);
    constexpr int NITEMS = I_IN + 2 * I_SQ + 2 * I_G + I_DN + I_QKV + NE * (2 * I_MG + I_MD);
    for (int it = gw; it < NITEMS; it += NGW) {
        int r = it;
        if (r < I_IN) { p0_transpose_item(F.w_in, D, N_IN, F.Wt_in, scr, r, F.lane, 0); continue; } r -= I_IN;
        if (r < I_SQ) { p0_transpose_item(F.w_ho, D, D, F.Wt_ho, scr, r, F.lane, 0); continue; } r -= I_SQ;
        if (r < I_G) { p0_transpose_item(F.w_g, D, FFN, F.Wt_gu, scr, r, F.lane, 1); continue; } r -= I_G;
        if (r < I_G) { p0_transpose_item(F.w_u, D, FFN, F.Wt_gu, scr, r, F.lane, 2); continue; } r -= I_G;
        if (r < I_DN) { p0_transpose_item(F.w_d, FFN, D, F.Wt_dn, scr, r, F.lane, 0); continue; } r -= I_DN;
        if (r < I_QKV) { p0_transpose_item(F.w_qkv, D, NQKV, F.Wt_qkv, scr, r, F.lane, 0); continue; } r -= I_QKV;
        if (r < I_SQ) { p0_transpose_item(F.w_ao, D, D, F.Wt_ao, scr, r, F.lane, 0); continue; } r -= I_SQ;
        if (r < NE * I_MG) { const int e = r / I_MG; p0_transpose_item(F.mw_g + (size_t)e * D * FE, D, FE, F.Wt_mgu + (size_t)e * NMGU * D, scr, r % I_MG, F.lane, 1); continue; } r -= NE * I_MG;
        if (r < NE * I_MG) { const int e = r / I_MG; p0_transpose_item(F.mw_u + (size_t)e * D * FE, D, FE, F.Wt_mgu + (size_t)e * NMGU * D, scr, r % I_MG, F.lane, 2); continue; } r -= NE * I_MG;
        { const int e = r / I_MD; p0_transpose_item(F.mw_d + (size_t)e * FE * D, FE, D, F.Wt_mdn + (size_t)e * D * FE, scr, r % I_MD, F.lane, 0); }
    }
    rms_phase(F, F.x, F.gains, F.hn);
}

__device__ __forceinline__ void scan_phase(Frame& F) {
    LAS float* sQ = (LAS float*)F.lds;
    LAS float* sF = sQ + 64 * 128;
    LAS float* sV = sF + 64 * 128;
    LAS float* sO = sV + 64 * 64;
    const int tid = F.tid, lane = F.lane, w = F.wave, kg = lane >> 3, vi = lane & 7;
    const int cg = tid & 15, r0 = tid >> 4, vr = tid >> 3, vc = tid & 7;
    const bf16* proj = F.big;
    for (int unit = blockIdx.x; unit < 256; unit += F.G) {
        const int half = unit & 1, dir = (unit >> 1) & 1, h = (unit >> 2) & 15, b = unit >> 6;
        float lbv[8];
#pragma unroll
        for (int j = 0; j < 8; ++j) { const int col = h * 128 + cg * 8 + j;
            const float l0 = F.lbl[(0 * 2 + dir) * 2048 + col], l1 = F.lbl[(1 * 2 + dir) * 2048 + col], l2 = F.lbl[(2 * 2 + dir) * 2048 + col];
            const float mx = fmaxf(l0, fmaxf(l1, l2)); const float e0 = expf(l0 - mx), e1 = expf(l1 - mx), e2 = expf(l2 - mx); lbv[j] = e0 / (e0 + e1 + e2); }
        const bf16* pb = proj + (size_t)(b * SEQ) * N_IN;
        const int qcol = h * 128 + cg * 8, fcol = 2048 * (1 + dir) + h * 128 + cg * 8, vcol = 6144 + h * 128 + half * 64 + vc * 8;
        bf16* obase = F.of + (size_t)dir * T * D + (size_t)(b * SEQ) * D + h * 128 + half * 64 + vc * 8;
        float S[16];
#pragma unroll
        for (int i = 0; i < 16; ++i) S[i] = 0.f;
        v4u rq[2], rf[2], rv;
#define SCAN_TOK(c, tt) (dir ? (SEQ - 1 - ((c) * 64 + (tt))) : ((c) * 64 + (tt)))
#define SCAN_LOAD(c) do { _Pragma("unroll") for (int i = 0; i < 2; ++i) { const size_t ro = (size_t)SCAN_TOK(c, r0 + 32 * i) * N_IN; rq[i] = *(const GAS v4u*)(pb + ro + qcol); rf[i] = *(const GAS v4u*)(pb + ro + fcol); } \
        rv = *(const GAS v4u*)(pb + (size_t)SCAN_TOK(c, vr) * N_IN + vcol); } while (0)
        SCAN_LOAD(0);
        for (int c = 0; c < 64; ++c) {
            if (c > 0) { __syncthreads();
                const LAS f32x4* so = (const LAS f32x4*)(sO + vr * 64 + vc * 8); const f32x4 a = so[0], bq = so[1];
                v4u o; o.x = pk2(a.x, a.y); o.y = pk2(a.z, a.w); o.z = pk2(bq.x, bq.y); o.w = pk2(bq.z, bq.w);
                *(GAS v4u*)(obase + (size_t)SCAN_TOK(c - 1, vr) * D) = o; }
#pragma unroll
            for (int i = 0; i < 2; ++i) {
                const unsigned qw[4] = {rq[i].x, rq[i].y, rq[i].z, rq[i].w}, fw[4] = {rf[i].x, rf[i].y, rf[i].z, rf[i].w};
                float qs[8], fs[8];
#pragma unroll
                for (int j = 0; j < 4; ++j) { const float q0 = bflo(qw[j]), q1 = bfhi(qw[j]), f0 = bflo(fw[j]), f1 = bfhi(fw[j]);
                    qs[2 * j] = q0 * __builtin_amdgcn_rcpf(1.0f + __expf(-q0)); qs[2 * j + 1] = q1 * __builtin_amdgcn_rcpf(1.0f + __expf(-q1));
                    const float s0 = __builtin_amdgcn_rcpf(1.0f + __expf(-f0)), s1 = __builtin_amdgcn_rcpf(1.0f + __expf(-f1));
                    fs[2 * j] = lbv[2 * j] + (1.0f - lbv[2 * j]) * s0; fs[2 * j + 1] = lbv[2 * j + 1] + (1.0f - lbv[2 * j + 1]) * s1; }
                LAS f32x4* dq = (LAS f32x4*)(sQ + (r0 + 32 * i) * 128 + cg * 8); LAS f32x4* df = (LAS f32x4*)(sF + (r0 + 32 * i) * 128 + cg * 8);
                dq[0] = (f32x4){qs[0], qs[1], qs[2], qs[3]}; dq[1] = (f32x4){qs[4], qs[5], qs[6], qs[7]};
                df[0] = (f32x4){fs[0], fs[1], fs[2], fs[3]}; df[1] = (f32x4){fs[4], fs[5], fs[6], fs[7]};
            }
            { LAS f32x4* dv = (LAS f32x4*)(sV + vr * 64 + vc * 8);
              dv[0] = (f32x4){bflo(rv.x), bfhi(rv.x), bflo(rv.y), bfhi(rv.y)}; dv[1] = (f32x4){bflo(rv.z), bfhi(rv.z), bflo(rv.w), bfhi(rv.w)}; }
            if (c + 1 < 64) SCAN_LOAD(c + 1);
            __syncthreads();
#pragma unroll 2
            for (int tt = 0; tt < 64; ++tt) {
                const LAS f32x4* q4 = (const LAS f32x4*)(sQ + tt * 128 + kg * 16); const LAS f32x4* f4 = (const LAS f32x4*)(sF + tt * 128 + kg * 16);
                const float v = sV[tt * 64 + w * 8 + vi];
                float o0 = 0.f, o1 = 0.f, o2 = 0.f, o3 = 0.f;
#pragma unroll
                for (int i = 0; i < 4; ++i) { const f32x4 qv = q4[i], fv = f4[i];
                    S[4 * i + 0] = fmaf(fv.x, S[4 * i + 0] - v, v); o0 = fmaf(qv.x, S[4 * i + 0], o0);
                    S[4 * i + 1] = fmaf(fv.y, S[4 * i + 1] - v, v); o1 = fmaf(qv.y, S[4 * i + 1], o1);
                    S[4 * i + 2] = fmaf(fv.z, S[4 * i + 2] - v, v); o2 = fmaf(qv.z, S[4 * i + 2], o2);
                    S[4 * i + 3] = fmaf(fv.w, S[4 * i + 3] - v, v); o3 = fmaf(qv.w, S[4 * i + 3], o3); }
                float o = (o0 + o1) + (o2 + o3);
                o += __shfl_xor(o, 8); o += __shfl_xor(o, 16); o += __shfl_xor(o, 32);
                if (kg == 0) sO[tt * 64 + w * 8 + vi] = o;
            }
        }
        __syncthreads();
        { const LAS f32x4* so = (const LAS f32x4*)(sO + vr * 64 + vc * 8); const f32x4 a = so[0], bq = so[1];
          v4u o; o.x = pk2(a.x, a.y); o.y = pk2(a.z, a.w); o.z = pk2(bq.x, bq.y); o.w = pk2(bq.z, bq.w);
          *(GAS v4u*)(obase + (size_t)SCAN_TOK(63, vr) * D) = o; }
        __syncthreads();
#undef SCAN_TOK
#undef SCAN_LOAD
    }
}

__device__ __forceinline__ void onorm_phase(Frame& F) {
    const int gw = F.vcu * NWAVES + F.wave, NGW = F.G * NWAVES, lane = F.lane;
    const bf16* proj = F.big;
    for (int m = gw; m < T; m += NGW) {
#pragma unroll
        for (int pass = 0; pass < 4; ++pass) {
            const int c0 = (pass * 64 + lane) * 8;
            const v4u a = *(const GAS v4u*)(F.of + (size_t)m * D + c0), bq = *(const GAS v4u*)(F.of + (size_t)T * D + (size_t)m * D + c0);
            const v4u gt = *(const GAS v4u*)(proj + (size_t)m * N_IN + 8192 + c0);
            const f32x4 g0 = *(const GAS f32x4*)(F.onorm + c0), g1 = *(const GAS f32x4*)(F.onorm + c0 + 4);
            const unsigned aw[4] = {a.x, a.y, a.z, a.w}, bw[4] = {bq.x, bq.y, bq.z, bq.w}, gw4[4] = {gt.x, gt.y, gt.z, gt.w};
            const float gn[8] = {g0.x, g0.y, g0.z, g0.w, g1.x, g1.y, g1.z, g1.w};
            float o[8], ss = 0.f;
#pragma unroll
            for (int j = 0; j < 4; ++j) { o[2 * j] = bflo(aw[j]) + bflo(bw[j]); o[2 * j + 1] = bfhi(aw[j]) + bfhi(bw[j]); ss += o[2 * j] * o[2 * j] + o[2 * j + 1] * o[2 * j + 1]; }
            ss += __shfl_xor(ss, 1); ss += __shfl_xor(ss, 2); ss += __shfl_xor(ss, 4); ss += __shfl_xor(ss, 8);
            const float r = 1.0f / sqrtf(ss * (1.f / 128.f) + EPS);
            float y[8];
#pragma unroll
            for (int j = 0; j < 4; ++j) { const float t0 = bflo(gw4[j]), t1 = bfhi(gw4[j]);
                y[2 * j] = o[2 * j] * r * gn[2 * j] * (t0 * __builtin_amdgcn_rcpf(1.0f + __expf(-t0)));
                y[2 * j + 1] = o[2 * j + 1] * r * gn[2 * j + 1] * (t1 * __builtin_amdgcn_rcpf(1.0f + __expf(-t1))); }
            v4u w; w.x = pk2(y[0], y[1]); w.y = pk2(y[2], y[3]); w.z = pk2(y[4], y[5]); w.w = pk2(y[6], y[7]);
            *(GAS v4u*)(F.ob + (size_t)m * D + c0) = w;
        }
    }
}

__device__ __forceinline__ void qknorm_rope_phase(Frame& F) {
    const int gw = F.vcu * NWAVES + F.wave, NGW = F.G * NWAVES, lane = F.lane;
    bf16* qkv = F.big;
    const float inv = expf(-(float)lane * (2.0f / 128.0f) * 9.210340371976184f);
    const float qg1 = F.qgain[lane], qg2 = F.qgain[lane + 64], kg1 = F.kgain[lane], kg2 = F.kgain[lane + 64];
    for (int m = gw; m < T; m += NGW) {
        const float pos = (float)(m & (SEQ - 1));
        float rev = pos * inv * 0.15915494309189535f; rev -= floorf(rev);
        const float sn = __builtin_amdgcn_sinf(rev), cs = __builtin_amdgcn_cosf(rev);
#pragma unroll 4
        for (int vec = 0; vec < 32; ++vec) {
            const bool isq = vec < 16; bf16* base = qkv + (size_t)m * NQKV + (isq ? 0 : 2048) + (vec & 15) * 128;
            const float x1 = bf2f(base[lane]), x2 = bf2f(base[lane + 64]);
            const float ss = wave_sum(x1 * x1 + x2 * x2);
            const float r = 1.0f / sqrtf(ss * (1.f / 128.f) + EPS);
            const float y1 = x1 * r * (isq ? qg1 : kg1), y2 = x2 * r * (isq ? qg2 : kg2);
            float o1 = y1 * cs - y2 * sn, o2 = y2 * cs + y1 * sn;
            if (isq) { o1 *= 0.08838834764831845f; o2 *= 0.08838834764831845f; }
            base[lane] = (bf16)f2bf(o1); base[lane + 64] = (bf16)f2bf(o2);
        }
    }
}

constexpr int ATT_KP = 272;
constexpr int ATT_GRP_BYTES = 2 * 64 * ATT_KP;
__device__ __forceinline__ void attn_phase(Frame& F) {
    const int tid = F.tid, lane = F.lane, w = F.wave, gsel = w >> 2, qi = w & 3, gtid = tid & 255;
    const int l15 = lane & 15, g = lane >> 4;
    LAS unsigned char* Kl = F.lds + gsel * ATT_GRP_BYTES; LAS unsigned char* Vl = Kl + 64 * ATT_KP;
    const bf16* qkv = F.big;
    bf16* obr = F.of; float* lse = F.lse;
    constexpr int NPAIR = 64 * 3 * 64 / 2;
    const int per = (NPAIR + F.G - 1) / F.G, p_lo = F.vcu * per, p_hi = (p_lo + per < NPAIR) ? p_lo + per : NPAIR;
    const int nit = (p_hi > p_lo) ? (p_hi - p_lo) * 3 : 0;
    v4u R[8];
    int b = 0, h = 0, br = 0, r = 1, n = SEQ, cls = 0, nb = 0;
    bf16x8 Qf[4]; f32x4 Ot[8]; float mrow = -1e30f, lrow = 0.f;
#define ATT_UNIT(it_) do { const int uid = 2 * (p_lo + (it_) / 3) + gsel; const int bh = uid / 192, rem = uid % 192; br = rem / 64; const int idx = rem % 64; \
        b = bh >> 4; h = bh & 15; r = (br == 0) ? 1 : ((br == 1) ? 4 : 16); n = SEQ / r; const int nbk = 64 / r; cls = idx / nbk; nb = idx % nbk; } while (0)
#define ATT_PREFETCH(it_) do { int b_, h_, r_, n_, cls_, nb_; { const int uid = 2 * (p_lo + (it_) / 3) + gsel; const int bh = uid / 192, rem = uid % 192; const int br_ = rem / 64, idx = rem % 64; \
            b_ = bh >> 4; h_ = bh & 15; r_ = (br_ == 0) ? 1 : ((br_ == 1) ? 4 : 16); n_ = SEQ / r_; const int nbk = 64 / r_; cls_ = idx / nbk; nb_ = idx % nbk; } \
        const int kp0 = 64 * (nb_ - 1 + (it_) % 3); \
        _Pragma("unroll") for (int i = 0; i < 4; ++i) { const int idx = gtid + 256 * i, row = idx >> 4, ch = idx & 15; int kp = kp0 + row; kp = kp < 0 ? 0 : (kp >= n_ ? n_ - 1 : kp); \
            const bf16* src = qkv + (size_t)(b_ * SEQ + cls_ + r_ * kp) * NQKV + 2048 + h_ * 128 + ch * 8; R[i] = *(const GAS v4u*)src; R[4 + i] = *(const GAS v4u*)(src + 2048); } } while (0)
    if (nit > 0) ATT_PREFETCH(0);
    for (int it = 0; it < nit; ++it) {
        const int kb = it % 3;
        __syncthreads();
#pragma unroll
        for (int i = 0; i < 4; ++i) { const int idx = gtid + 256 * i, row = idx >> 4, ch = idx & 15; *(LAS v4u*)(Kl + row * ATT_KP + ch * 16) = R[i]; *(LAS v4u*)(Vl + row * ATT_KP + ch * 16) = R[4 + i]; }
        if (it + 1 < nit) ATT_PREFETCH(it + 1);
        __syncthreads();
        if (kb == 0) {
            ATT_UNIT(it);
            const int pq = 64 * nb + 16 * qi + l15; const bf16* qsrc = qkv + (size_t)(b * SEQ + cls + r * pq) * NQKV + h * 128 + 8 * g;
#pragma unroll
            for (int s = 0; s < 4; ++s) Qf[s] = *(const GAS bf16x8*)(qsrc + 32 * s);
#pragma unroll
            for (int c = 0; c < 8; ++c) Ot[c] = (f32x4){0.f, 0.f, 0.f, 0.f};
            mrow = -1e30f; lrow = 0.f;
        }
        const int pq = 64 * nb + 16 * qi + l15, kp0 = 64 * (nb - 1 + kb);
        f32x4 sc[4];
#pragma unroll
        for (int kt = 0; kt < 4; ++kt) { sc[kt] = (f32x4){0.f, 0.f, 0.f, 0.f};
#pragma unroll
            for (int s = 0; s < 4; ++s) { const bf16x8 kf = *(const LAS bf16x8*)(Kl + (16 * kt + l15) * ATT_KP + (32 * s + 8 * g) * 2);
                sc[kt] = __builtin_amdgcn_mfma_f32_16x16x32_bf16(kf, Qf[s], sc[kt], 0, 0, 0); } }
        float mx = -1e30f; bool valid[4][4];
#pragma unroll
        for (int kt = 0; kt < 4; ++kt)
#pragma unroll
            for (int e = 0; e < 4; ++e) { const int kp = kp0 + 16 * kt + 4 * g + e; const int d = kp - pq; valid[kt][e] = (kp >= 0) && (kp < n) && (d <= 64) && (d >= -64); if (valid[kt][e]) mx = fmaxf(mx, sc[kt][e]); }
        mx = fmaxf(mx, __shfl_xor(mx, 16)); mx = fmaxf(mx, __shfl_xor(mx, 32));
        const float mnew = fmaxf(mrow, mx), alpha = __expf(mrow - mnew);
        float rs = 0.f; float p[4][4];
#pragma unroll
        for (int kt = 0; kt < 4; ++kt)
#pragma unroll
            for (int e = 0; e < 4; ++e) { p[kt][e] = valid[kt][e] ? __expf(sc[kt][e] - mnew) : 0.f; rs += p[kt][e]; }
        rs += __shfl_xor(rs, 16); rs += __shfl_xor(rs, 32);
        lrow = lrow * alpha + rs; mrow = mnew;
#pragma unroll
        for (int c = 0; c < 8; ++c) Ot[c] = Ot[c] * alpha;
#pragma unroll
        for (int ks = 0; ks < 2; ++ks) {
            union { bf16x8 v; unsigned u[4]; } pf;
            pf.u[0] = pk2(p[2 * ks][0], p[2 * ks][1]); pf.u[1] = pk2(p[2 * ks][2], p[2 * ks][3]); pf.u[2] = pk2(p[2 * ks + 1][0], p[2 * ks + 1][1]); pf.u[3] = pk2(p[2 * ks + 1][2], p[2 * ks + 1][3]);
            const unsigned q4 = (unsigned)l15 >> 2, p4 = (unsigned)lane & 3u;
            const unsigned va = (unsigned)(size_t)Vl + (32u * ks + 4u * g + q4) * ATT_KP + p4 * 8u;
            v2u t0[8], t1[8];
            asm volatile(
                "ds_read_b64_tr_b16 %0, %16 offset:0\n\tds_read_b64_tr_b16 %1, %16 offset:32\n\tds_read_b64_tr_b16 %2, %16 offset:64\n\tds_read_b64_tr_b16 %3, %16 offset:96\n\t"
                "ds_read_b64_tr_b16 %4, %16 offset:128\n\tds_read_b64_tr_b16 %5, %16 offset:160\n\tds_read_b64_tr_b16 %6, %16 offset:192\n\tds_read_b64_tr_b16 %7, %16 offset:224\n\t"
                "ds_read_b64_tr_b16 %8, %17 offset:0\n\tds_read_b64_tr_b16 %9, %17 offset:32\n\tds_read_b64_tr_b16 %10, %17 offset:64\n\tds_read_b64_tr_b16 %11, %17 offset:96\n\t"
                "ds_read_b64_tr_b16 %12, %17 offset:128\n\tds_read_b64_tr_b16 %13, %17 offset:160\n\tds_read_b64_tr_b16 %14, %17 offset:192\n\tds_read_b64_tr_b16 %15, %17 offset:224\n\t"
                "s_waitcnt lgkmcnt(0)"
                : "=&v"(t0[0]), "=&v"(t0[1]), "=&v"(t0[2]), "=&v"(t0[3]), "=&v"(t0[4]), "=&v"(t0[5]), "=&v"(t0[6]), "=&v"(t0[7]),
                  "=&v"(t1[0]), "=&v"(t1[1]), "=&v"(t1[2]), "=&v"(t1[3]), "=&v"(t1[4]), "=&v"(t1[5]), "=&v"(t1[6]), "=&v"(t1[7])
                : "v"(va), "v"(va + 16u * ATT_KP) : "memory");
#pragma unroll
            for (int c = 0; c < 8; ++c) { union { bf16x8 v; unsigned u[4]; } vf; vf.u[0] = t0[c].x; vf.u[1] = t0[c].y; vf.u[2] = t1[c].x; vf.u[3] = t1[c].y;
                Ot[c] = __builtin_amdgcn_mfma_f32_16x16x32_bf16(vf.v, pf.v, Ot[c], 0, 0, 0); }
        }
        if (kb == 2) {
            const float il = 1.0f / lrow; const size_t mrowi = (size_t)(b * SEQ + cls + r * pq);
            bf16* op = obr + (size_t)br * T * D + mrowi * D + h * 128 + 4 * g;
#pragma unroll
            for (int c = 0; c < 8; ++c) { v2u wv; wv.x = pk2(Ot[c][0] * il, Ot[c][1] * il); wv.y = pk2(Ot[c][2] * il, Ot[c][3] * il); *(GAS v2u*)(op + 16 * c) = wv; }
            if (g == 0) lse[(size_t)br * T * NH + mrowi * NH + h] = mrow + __logf(lrow);
        }
    }
#undef ATT_UNIT
#undef ATT_PREFETCH
}
__device__ __forceinline__ void attn_combine_phase(Frame& F) {
    const int gw = F.vcu * NWAVES + F.wave, NGW = F.G * NWAVES, lane = F.lane;
    for (int m = gw; m < T; m += NGW) {
#pragma unroll
        for (int pass = 0; pass < 4; ++pass) {
            const int c0 = (pass * 64 + lane) * 8, hh = c0 >> 7;
            const float l0 = F.lse[(size_t)m * NH + hh], l1 = F.lse[(size_t)T * NH + (size_t)m * NH + hh], l2 = F.lse[(size_t)2 * T * NH + (size_t)m * NH + hh];
            const float mx = fmaxf(l0, fmaxf(l1, l2)); const float e0 = __expf(l0 - mx), e1 = __expf(l1 - mx), e2 = __expf(l2 - mx); const float is = 1.0f / (e0 + e1 + e2);
            const float w0 = e0 * is, w1 = e1 * is, w2 = e2 * is;
            const v4u a = *(const GAS v4u*)(F.of + (size_t)m * D + c0), bq = *(const GAS v4u*)(F.of + (size_t)T * D + (size_t)m * D + c0), cq = *(const GAS v4u*)(F.of + (size_t)2 * T * D + (size_t)m * D + c0);
            const unsigned aw[4] = {a.x, a.y, a.z, a.w}, bw[4] = {bq.x, bq.y, bq.z, bq.w}, cw[4] = {cq.x, cq.y, cq.z, cq.w};
            unsigned o[4];
#pragma unroll
            for (int j = 0; j < 4; ++j) o[j] = pk2(w0 * bflo(aw[j]) + w1 * bflo(bw[j]) + w2 * bflo(cw[j]), w0 * bfhi(aw[j]) + w1 * bfhi(bw[j]) + w2 * bfhi(cw[j]));
            *(GAS v4u*)(F.ob + (size_t)m * D + c0) = (v4u){o[0], o[1], o[2], o[3]};
        }
    }
}

__device__ __forceinline__ void router_phase(Frame& F) {
    const int tid = F.tid, lane = F.lane, w = F.wave;
    LAS int* sE = (LAS int*)F.lds;
    LAS float* sG = (LAS float*)(F.lds + 512);
    LAS int* lcnt = (LAS int*)(F.lds + 1024);
    LAS int* gbase = (LAS int*)(F.lds + 1088);
    const float* gain = F.gains + 3 * D;
    for (int blk = blockIdx.x; blk < T / 64; blk += F.G) {
        if (tid < 8) lcnt[tid] = 0;
        for (int i = 0; i < 8; ++i) {
            const int ti = w * 8 + i, m = blk * 64 + ti;
            const GAS f32x4* xr = (const GAS f32x4*)(F.out + (size_t)m * D) + lane; const GAS f32x4* gr = (const GAS f32x4*)gain + lane;
            f32x4 v[8]; float s = 0.f;
#pragma unroll
            for (int j = 0; j < 8; ++j) { v[j] = xr[64 * j]; s += (v[j].x * v[j].x + v[j].y * v[j].y) + (v[j].z * v[j].z + v[j].w * v[j].w); }
            const float r = 1.0f / sqrtf(wave_sum(s) * (1.f / D) + EPS);
            float lg[8];
#pragma unroll
            for (int e = 0; e < 8; ++e) lg[e] = 0.f;
            GAS v2u* o8 = (GAS v2u*)(F.hn + (size_t)m * D) + lane;
#pragma unroll
            for (int j = 0; j < 8; ++j) { const f32x4 g = gr[64 * j]; const float y[4] = {v[j].x * r * g.x, v[j].y * r * g.y, v[j].z * r * g.z, v[j].w * r * g.w};
                v2u wv; wv.x = pk2(y[0], y[1]); wv.y = pk2(y[2], y[3]); o8[64 * j] = wv;
                const GAS f32x4* wr4 = (const GAS f32x4*)(F.w_r + (size_t)(4 * (lane + 64 * j)) * NE);
#pragma unroll
                for (int q = 0; q < 4; ++q) { const f32x4 wa = wr4[2 * q], wb = wr4[2 * q + 1];
                    lg[0] = fmaf(y[q], wa.x, lg[0]); lg[1] = fmaf(y[q], wa.y, lg[1]); lg[2] = fmaf(y[q], wa.z, lg[2]); lg[3] = fmaf(y[q], wa.w, lg[3]);
                    lg[4] = fmaf(y[q], wb.x, lg[4]); lg[5] = fmaf(y[q], wb.y, lg[5]); lg[6] = fmaf(y[q], wb.z, lg[6]); lg[7] = fmaf(y[q], wb.w, lg[7]); } }
#pragma unroll
            for (int e = 0; e < 8; ++e) lg[e] = wave_sum(lg[e]);
            int e0 = 0; float b0 = lg[0];
#pragma unroll
            for (int e = 1; e < 8; ++e) if (lg[e] > b0) { b0 = lg[e]; e0 = e; }
            int e1 = -1; float b1 = -3.0e38f;
#pragma unroll
            for (int e = 0; e < 8; ++e) if (e != e0 && lg[e] > b1) { b1 = lg[e]; e1 = e; }
            const float g1 = 1.0f / (1.0f + __expf(b0 - b1)), g0 = 1.0f - g1;
            if (lane == 0) { sE[2 * ti] = e0; sE[2 * ti + 1] = e1; sG[2 * ti] = g0; sG[2 * ti + 1] = g1; }
        }
        __syncthreads();
        int e0 = 0, e1 = 0, r0 = 0, r1 = 0;
        if (tid < 64) { e0 = sE[2 * tid]; e1 = sE[2 * tid + 1]; r0 = atomicAdd((int*)&lcnt[e0], 1); r1 = atomicAdd((int*)&lcnt[e1], 1); }
        __syncthreads();
        if (tid < 8) gbase[tid] = (int)__hip_atomic_fetch_add(F.ctl + CW_MOE + 64 * tid, (unsigned)lcnt[tid], RLX_AGENT);
        __syncthreads();
        if (tid < 64) { const int m = blk * 64 + tid; int* rc = F.rec + (size_t)m * 8;
            rc[0] = e0; rc[1] = gbase[e0] + r0; rc[2] = e1; rc[3] = gbase[e1] + r1; rc[4] = __builtin_bit_cast(int, sG[2 * tid]); rc[5] = __builtin_bit_cast(int, sG[2 * tid + 1]); }
        __syncthreads();
    }
}
__device__ __forceinline__ void moe_tiles(Frame& F, int (&cnt)[8], int (&ct)[9]) {
    ct[0] = 0;
#pragma unroll
    for (int e = 0; e < 8; ++e) { cnt[e] = (int)__hip_atomic_load(F.ctl + CW_MOE + 64 * e, RLX_AGENT); ct[e + 1] = ct[e] + ((cnt[e] + 255) >> 8); }
}
__device__ __forceinline__ void gather_phase(Frame& F) {
    const int gw = F.vcu * NWAVES + F.wave, NGW = F.G * NWAVES, lane = F.lane;
    int cnt[8], ct[9]; moe_tiles(F, cnt, ct);
    for (int m = gw; m < T; m += NGW) {
        const int* rc = F.rec + (size_t)m * 8;
        const int e0 = rc[0], r0 = rc[1], e1 = rc[2], r1 = rc[3];
        int o0 = 0, o1 = 0;
#pragma unroll
        for (int e = 0; e < 8; ++e) { if (e == e0) o0 = ct[e]; if (e == e1) o1 = ct[e]; }
        const int s0 = o0 * 256 + r0, s1 = o1 * 256 + r1;
        const GAS v4u* src = (const GAS v4u*)(F.hn + (size_t)m * D) + lane;
        GAS v4u* d0 = (GAS v4u*)(F.xg + (size_t)s0 * D) + lane; GAS v4u* d1 = (GAS v4u*)(F.xg + (size_t)s1 * D) + lane;
#pragma unroll
        for (int j = 0; j < 4; ++j) { const v4u v = src[64 * j]; d0[64 * j] = v; d1[64 * j] = v; }
        if (lane == 0) { F.tslot[2 * m] = s0; F.tslot[2 * m + 1] = s1; }
    }
    for (int i = gw; i < 8 * 256; i += NGW) {
        const int e = i >> 8, j = i & 255; int c = 0, o = 0, nt = 0;
#pragma unroll
        for (int q = 0; q < 8; ++q) if (q == e) { c = cnt[q]; o = ct[q]; nt = ct[q + 1] - ct[q]; }
        const int row = o * 256 + c + j;
        if (c + j < nt * 256) { GAS v4u* d = (GAS v4u*)(F.xg + (size_t)row * D) + lane;
#pragma unroll
            for (int q = 0; q < 4; ++q) d[64 * q] = (v4u){0u, 0u, 0u, 0u}; }
    }
}
__device__ __forceinline__ void moe_combine_phase(Frame& F) {
    const int gw = F.vcu * NWAVES + F.wave, NGW = F.G * NWAVES, lane = F.lane;
    const bf16* y = F.xg;
    for (int m = gw; m < T; m += NGW) {
        const int s0 = F.tslot[2 * m], s1 = F.tslot[2 * m + 1];
        const float g0 = __builtin_bit_cast(float, F.rec[(size_t)m * 8 + 4]), g1 = __builtin_bit_cast(float, F.rec[(size_t)m * 8 + 5]);
#pragma unroll
        for (int pass = 0; pass < 4; ++pass) {
            const int c0 = (pass * 64 + lane) * 8;
            const v4u a = *(const GAS v4u*)(y + (size_t)s0 * D + c0), bq = *(const GAS v4u*)(y + (size_t)s1 * D + c0);
            float* op = F.out + (size_t)m * D + c0; f32x4 x0 = *(const GAS f32x4*)op, x1 = *(const GAS f32x4*)(op + 4);
            x0.x += g0 * bflo(a.x) + g1 * bflo(bq.x); x0.y += g0 * bfhi(a.x) + g1 * bfhi(bq.x); x0.z += g0 * bflo(a.y) + g1 * bflo(bq.y); x0.w += g0 * bfhi(a.y) + g1 * bfhi(bq.y);
            x1.x += g0 * bflo(a.z) + g1 * bflo(bq.z); x1.y += g0 * bfhi(a.z) + g1 * bfhi(bq.z); x1.z += g0 * bflo(a.w) + g1 * bflo(bq.w); x1.w += g0 * bfhi(a.w) + g1 * bfhi(bq.w);
            *(GAS f32x4*)op = x0; *(GAS f32x4*)(op + 4) = x1;
        }
    }
}

#ifndef MK_PER_PHASE
#define MK_PER_PHASE 1
#endif
struct Args { const float* in[17]; float* out; unsigned char* ws; int ph_lo, ph_hi; };
__global__ void __launch_bounds__(NTHREADS, 2) mk_fwd(Args args) {
    extern __shared__ __attribute__((aligned(16))) unsigned char lds[];
    Frame F;
    F.lds = (LAS unsigned char*)lds;
    F.tid = threadIdx.x; F.lane = F.tid & 63; F.wave = __builtin_amdgcn_readfirstlane(F.tid >> 6);
    F.G = gridDim.x; { const int bx = blockIdx.x; F.vcu = (F.G % 8 == 0) ? (bx % 8) * (F.G / 8) + bx / 8 : bx; }
    unsigned char* ws = args.ws;
    F.ctl = (unsigned*)(ws + WS_CTL);
    F.x = args.in[0]; F.gains = args.in[1]; F.w_in = args.in[2]; F.lbl = args.in[3]; F.onorm = args.in[4]; F.w_ho = args.in[5]; F.w_qkv = args.in[6]; F.qgain = args.in[7]; F.kgain = args.in[8];
    F.w_ao = args.in[9]; F.w_g = args.in[10]; F.w_u = args.in[11]; F.w_d = args.in[12]; F.w_r = args.in[13]; F.mw_g = args.in[14]; F.mw_u = args.in[15]; F.mw_d = args.in[16]; F.out = args.out;
    F.Wt_in = (bf16*)(ws + WS_W_IN); F.Wt_ho = (bf16*)(ws + WS_W_HO); F.Wt_gu = (bf16*)(ws + WS_W_GU); F.Wt_dn = (bf16*)(ws + WS_W_DN); F.Wt_qkv = (bf16*)(ws + WS_W_QKV); F.Wt_ao = (bf16*)(ws + WS_W_AO);
    F.Wt_mgu = (bf16*)(ws + WS_W_MGU); F.Wt_mdn = (bf16*)(ws + WS_W_MDN);
    F.hn = (bf16*)(ws + A_HN); F.big = (bf16*)(ws + A_BIG); F.of = (bf16*)(ws + A_OF); F.ob = (bf16*)(ws + A_OB); F.xg = (bf16*)(ws + A_XG); F.mh = (bf16*)(ws + A_MH);
    F.lse = (float*)(ws + A_LSE); F.rec = (int*)(ws + A_REC); F.tslot = (int*)(ws + A_TSLOT);
    volatile LAS unsigned* MISC = (volatile LAS unsigned*)(F.lds + MISC_OFF);
    if (F.tid < 32) MISC[F.tid] = 0u;
    __syncthreads();
    const int lo = args.ph_lo, hi = args.ph_hi;
    XcdBarrier bar; bar.bar = F.ctl + CW_BAR; bar.x = 0; bar.st = nullptr;
    if (hi - lo > 1) bar = xcd_barrier_post(F.ctl + CW_BAR, MISC + 8);
#define IN(k) (lo <= (k) && (k) < hi)
#define SEAM(k) do { if (IN(k) && IN((k) + 1)) xcd_barrier(bar); } while (0)
    typedef pg8::StaticOrder SO;

    if (IN(0)) { p0_prologue(F); } SEAM(0);
    if (IN(1)) { pg8::Gemm g{F.hn, F.Wt_in, D}; SO S; S.init(T / 256, N_IN / 256, F.G, (int)blockIdx.x); pg8::EpiBf16 E{F.big, N_IN};
        pg8::gemm_phase<pg8::EpiBf16, SO, true, true>(F.lds, g, S, E); } SEAM(1);
    if (IN(2)) { scan_phase(F); } SEAM(2);
    if (IN(3)) { onorm_phase(F); } SEAM(3);
    if (IN(4)) { pg8::Gemm g{F.ob, F.Wt_ho, D}; SO S; S.init(T / 256, D / 256, F.G, (int)blockIdx.x); pg8::EpiResF32 E{F.x, F.out, D};
        pg8::gemm_phase<pg8::EpiResF32, SO, true, true>(F.lds, g, S, E); } SEAM(4);
    if (IN(5)) { rms_phase(F, F.out, F.gains + D, F.hn); } SEAM(5);
    if (IN(6)) { pg8::Gemm g{F.hn, F.Wt_gu, D}; SO S; S.init(T / 256, NGU / 256, F.G, (int)blockIdx.x); pg8::EpiSwiglu E{F.big, FFN};
        pg8::gemm_phase<pg8::EpiSwiglu, SO, true, true>(F.lds, g, S, E); } SEAM(6);
    if (IN(7)) { pg8::Gemm g{F.big, F.Wt_dn, FFN}; SO S; S.init(T / 256, D / 256, F.G, (int)blockIdx.x); pg8::EpiResF32 E{F.out, F.out, D};
        pg8::gemm_phase<pg8::EpiResF32, SO, true, true>(F.lds, g, S, E); } SEAM(7);
    if (IN(8)) { rms_phase(F, F.out, F.gains + 2 * D, F.hn); } SEAM(8);
    if (IN(9)) { pg8::Gemm g{F.hn, F.Wt_qkv, D}; SO S; S.init(T / 256, NQKV / 256, F.G, (int)blockIdx.x); pg8::EpiBf16 E{F.big, NQKV};
        pg8::gemm_phase<pg8::EpiBf16, SO, true, true>(F.lds, g, S, E); } SEAM(9);
    if (IN(10)) { qknorm_rope_phase(F); } SEAM(10);
    if (IN(11)) { attn_phase(F); } SEAM(11);
    if (IN(12)) { attn_combine_phase(F); } SEAM(12);
    if (IN(13)) { pg8::Gemm g{F.ob, F.Wt_ao, D}; SO S; S.init(T / 256, D / 256, F.G, (int)blockIdx.x); pg8::EpiResF32 E{F.out, F.out, D};
        pg8::gemm_phase<pg8::EpiResF32, SO, true, true>(F.lds, g, S, E); } SEAM(13);
    if (IN(14)) { router_phase(F); } SEAM(14);
    if (IN(15)) { gather_phase(F); } SEAM(15);
    if (IN(16)) { int cnt[8], ct[9]; moe_tiles(F, cnt, ct);
        pg8::Gemm g{F.xg, F.Wt_mgu, D}; pg8::MoeOrder S; S.init(ct[8], NMGU / 256, F.G, (int)blockIdx.x);
        S.c1 = ct[1]; S.c2 = ct[2]; S.c3 = ct[3]; S.c4 = ct[4]; S.c5 = ct[5]; S.c6 = ct[6]; S.c7 = ct[7]; S.estride = (size_t)NMGU * D * 2;
        pg8::EpiSwiglu E{F.mh, FE};
        pg8::gemm_phase<pg8::EpiSwiglu, pg8::MoeOrder, true, true>(F.lds, g, S, E); } SEAM(16);
    if (IN(17)) { int cnt[8], ct[9]; moe_tiles(F, cnt, ct);
        pg8::Gemm g{F.mh, F.Wt_mdn, FE}; pg8::MoeOrder S; S.init(ct[8], D / 256, F.G, (int)blockIdx.x);
        S.c1 = ct[1]; S.c2 = ct[2]; S.c3 = ct[3]; S.c4 = ct[4]; S.c5 = ct[5]; S.c6 = ct[6]; S.c7 = ct[7]; S.estride = (size_t)D * FE * 2;
        pg8::EpiBf16 E{F.xg, D};
        pg8::gemm_phase<pg8::EpiBf16, pg8::MoeOrder, true, true>(F.lds, g, S, E); } SEAM(17);
    if (IN(18)) { moe_combine_phase(F); }
#undef IN
#undef SEAM
}

extern "C" void kernel_launch(void* const* d_in, const int* in_sizes, int n_in, void* d_out, int out_size, void* d_ws, size_t ws_size, hipStream_t stream) {
    static int grid = 0;
    if (grid == 0) {
        if (n_in != 17 || out_size != T * D || ws_size < WS_END) { fprintf(stderr, "kernel_launch: unexpected shapes (n_in %d out %d ws %zu need %zu)\n", n_in, out_size, ws_size, (size_t)WS_END); grid = -1; return; }
        int dev = 0, cus = 0, per_cu = 0;
        if (hipGetDevice(&dev) != hipSuccess || hipDeviceGetAttribute(&cus, hipDeviceAttributeMultiprocessorCount, dev) != hipSuccess) { grid = -1; return; }
        if (hipFuncSetAttribute((const void*)mk_fwd, hipFuncAttributeMaxDynamicSharedMemorySize, LDS_BYTES) != hipSuccess) { fprintf(stderr, "kernel_launch: hipFuncSetAttribute failed\n"); grid = -1; return; }
        if (hipOccupancyMaxActiveBlocksPerMultiprocessor(&per_cu, (const void*)mk_fwd, NTHREADS, LDS_BYTES) != hipSuccess || per_cu < 1) { fprintf(stderr, "kernel_launch: occupancy query reports %d\n", per_cu); }
        (void)hipGetLastError();
        grid = cus;
    }
    if (grid < 0) return;
    (void)hipMemsetAsync((char*)d_ws + WS_CTL, 0, CTL_ZERO_BYTES, stream);
    Args a{};
    for (int i = 0; i < 17; ++i) a.in[i] = (const float*)d_in[i];
    a.out = (float*)d_out; a.ws = (unsigned char*)d_ws;
#if MK_PER_PHASE
    for (int p = 0; p < N_PHASES; ++p) { a.ph_lo = p; a.ph_hi = p + 1; hipLaunchKernelGGL(mk_fwd, dim3(grid), dim3(NTHREADS), LDS_BYTES, stream, a); }
#else
    a.ph_lo = 0; a.ph_hi = N_PHASES;
    hipLaunchKernelGGL(mk_fwd, dim3(grid), dim3(NTHREADS), LDS_BYTES, stream, a);
#endif
}
```

```cpp
#include <hip/hip_runtime.h>
#include <cstdio>
#include <cstdint>

namespace pg8 {
#define PG8_LAS __attribute__((address_space(3)))
typedef unsigned short bf16_t;
typedef short bf16x8 __attribute__((ext_vector_type(8)));
typedef float f32x4 __attribute__((ext_vector_type(4)));
typedef unsigned u32x4 __attribute__((ext_vector_type(4)));
constexpr int BM = 256, BK = 64, HALF = 128, HTB = HALF * BK * 2  , STAGE_BYTES = 8 * HTB, NXCD = 8, WGM = 8;

__host__ __device__ __forceinline__ int lds_byte(int r, int c) { const int st = (r >> 4) * 2 + (c >> 5), rr = r & 15, cc = c & 31, ob = rr * 64 + cc * 2; return st * 1024 + (ob ^ (((ob >> 9) & 1) << 5)); }
__host__ __device__ __forceinline__ void stage_rc(int b, int& R, int& C) { const int st = b / 1024, sb = b % 1024, swz = sb ^ (((sb >> 9) & 1) << 5); R = (st >> 1) * 16 + swz / 64; C = (st & 1) * 32 + (swz % 64) / 2; }
__host__ __device__ __forceinline__ int perm32(int rho) { const int n = rho >> 4, i = rho & 15; return 8 * (i >> 2) + 4 * n + (i & 3); }

struct Unit { int pm, pn; };
struct Gemm { const bf16_t* A; const bf16_t* Bt; int K; };

struct StaticOrder {
    int nM, nN, nwg, G, c;
    __host__ __device__ void init(int nM_, int nN_, int G_, int c_) { nM = nM_; nN = nN_; nwg = nM * nN; G = G_; c = c_; }
    __host__ __device__ bool next(int i, Unit& u) const {
        const long L = (long)i * G + c; if (L >= nwg) return false;
        int wgid = (int)L; { const int q = nwg / NXCD, r = nwg % NXCD, xcd = wgid % NXCD, off = wgid / NXCD; wgid = (xcd < r ? xcd * (q + 1) : r * (q + 1) + (xcd - r) * q) + off; }
        const int nig = WGM * nN, gid = wgid / nig, fm = gid * WGM, gsz = (nM - fm) < WGM ? (nM - fm) : WGM;
        u.pm = fm + ((wgid % nig) % gsz); u.pn = (wgid % nig) / gsz; return true;
    }
    __device__ __forceinline__ const char* a_ptr(const Gemm& g, const Unit& u, size_t tstep) const { return (const char*)g.A + (size_t)u.pm * tstep; }
    __device__ __forceinline__ const char* b_ptr(const Gemm& g, const Unit& u, size_t tstep) const { return (const char*)g.Bt + (size_t)u.pn * tstep; }
    __device__ __forceinline__ void a_ready(const Unit&) const {}
    __device__ __forceinline__ void done(const Unit&) const {}
};
struct MoeOrder : StaticOrder {
    int c1, c2, c3, c4, c5, c6, c7; size_t estride;
    __device__ __forceinline__ int expert(int pm) const { return (pm >= c1) + (pm >= c2) + (pm >= c3) + (pm >= c4) + (pm >= c5) + (pm >= c6) + (pm >= c7); }
    __device__ __forceinline__ const char* b_ptr(const Gemm& g, const Unit& u, size_t tstep) const { return (const char*)g.Bt + (size_t)expert(u.pm) * estride + (size_t)u.pn * tstep; }
};

__device__ __forceinline__ unsigned cvt_pk_bf16(float lo, float hi) { unsigned r; asm volatile("v_cvt_pk_bf16_f32 %0, %1, %2" : "=v"(r) : "v"(lo), "v"(hi)); return r; }
__device__ __forceinline__ float silu_f(float x) { return x * __builtin_amdgcn_rcpf(1.0f + __expf(-x)); }

struct EpiBf16 {
    static constexpr bool PERM = true, AFTER_DRAIN = false;
    bf16_t* O; int ldc;
    __device__ __forceinline__ void operator()(const f32x4 (&acc)[2][2][4][2], const Unit& u, int wr, int wc, int fr, int fq) const {
        const int row0 = u.pm * BM + wr * 64 + fr, col0 = u.pn * BM + wc * 32 + 8 * fq;
#pragma unroll
        for (int ai = 0; ai < 2; ++ai)
#pragma unroll
            for (int m = 0; m < 4; ++m) { bf16_t* rowp = O + (size_t)(row0 + ai * HALF + m * 16) * ldc + col0;
#pragma unroll
                for (int bj = 0; bj < 2; ++bj) { const f32x4 v0 = acc[ai][bj][m][0], v1 = acc[ai][bj][m][1];
                    u32x4 w; w.x = cvt_pk_bf16(v0[0], v0[1]); w.y = cvt_pk_bf16(v0[2], v0[3]); w.z = cvt_pk_bf16(v1[0], v1[1]); w.w = cvt_pk_bf16(v1[2], v1[3]);
                    *(u32x4*)(rowp + bj * HALF) = w; } }
    }
};
struct EpiSwiglu {
    static constexpr bool PERM = true, AFTER_DRAIN = false;
    bf16_t* O; int ldc;
    __device__ __forceinline__ void operator()(const f32x4 (&acc)[2][2][4][2], const Unit& u, int wr, int wc, int fr, int fq) const {
        const int row0 = u.pm * BM + wr * 64 + fr, col0 = u.pn * HALF + wc * 32 + 8 * fq;
#pragma unroll
        for (int ai = 0; ai < 2; ++ai)
#pragma unroll
            for (int m = 0; m < 4; ++m) { bf16_t* rowp = O + (size_t)(row0 + ai * HALF + m * 16) * ldc + col0;
                const f32x4 g0 = acc[ai][0][m][0], g1 = acc[ai][0][m][1], u0 = acc[ai][1][m][0], u1 = acc[ai][1][m][1];
                float h[8];
#pragma unroll
                for (int j = 0; j < 4; ++j) { h[j] = silu_f(g0[j]) * u0[j]; h[4 + j] = silu_f(g1[j]) * u1[j]; }
                u32x4 w; w.x = cvt_pk_bf16(h[0], h[1]); w.y = cvt_pk_bf16(h[2], h[3]); w.z = cvt_pk_bf16(h[4], h[5]); w.w = cvt_pk_bf16(h[6], h[7]);
                *(u32x4*)rowp = w; }
    }
};
struct EpiResF32 {
    static constexpr bool PERM = false, AFTER_DRAIN = false;
    const float* base; float* out; int ldc;
    __device__ __forceinline__ void operator()(const f32x4 (&acc)[2][2][4][2], const Unit& u, int wr, int wc, int fr, int fq) const {
        const int row0 = u.pm * BM + wr * 64 + fr, col0 = u.pn * BM + wc * 32 + 4 * fq;
#pragma unroll
        for (int ai = 0; ai < 2; ++ai)
#pragma unroll
            for (int m = 0; m < 4; ++m) { const size_t off = (size_t)(row0 + ai * HALF + m * 16) * ldc + col0;
#pragma unroll
                for (int bj = 0; bj < 2; ++bj)
#pragma unroll
                    for (int n = 0; n < 2; ++n) { const f32x4 bs = *(const f32x4*)(base + off + bj * HALF + n * 16); *(f32x4*)(out + off + bj * HALF + n * 16) = bs + acc[ai][bj][m][n]; }
                asm volatile("" ::: "memory"); }
    }
};

template <class Epi, class Sched, bool ALIGN_EPI = false, bool SP2 = false>
__device__ __forceinline__ void gemm_phase(PG8_LAS unsigned char* lds, const Gemm g, const Sched& S, const Epi& E) {
    const int tid = threadIdx.x, wid = __builtin_amdgcn_readfirstlane(tid >> 6), lane = tid & 63, wr = wid >> 2, wc = wid & 3, fr = lane & 15, fq = lane >> 4;
    const int K = g.K, nt = K / BK;
    unsigned voffA[2], voffB[2];
#pragma unroll
    for (int i = 0; i < 2; ++i) { int R, C; stage_rc(tid * 16 + i * 8192, R, C); const int Rb = Epi::PERM ? ((R & ~31) + perm32(R & 31)) : R;
        voffA[i] = (unsigned)(R * K + C) * 2u; voffB[i] = (unsigned)(Rb * K + C) * 2u; }
    const size_t kstep = (size_t)(BK * 2);
    const size_t hstep = (size_t)HALF * K * 2;
    const size_t tstep = 2 * hstep;
    const unsigned ldsw = (unsigned)wid * 1024u;
    const int aoff = lds_byte(wr * 64 + fr, fq * 8), boff = lds_byte(wc * 32 + fr, fq * 8);
#define PG8_SA(b, h) (((b) * 2 + (h)) * HTB)
#define PG8_SB(b, h) ((4 + (b) * 2 + (h)) * HTB)
#define PG8_STAGE(bufoff, gbase, voff) do { _Pragma("unroll") for (int _i = 0; _i < 2; ++_i) \
        __builtin_amdgcn_global_load_lds((const unsigned*)((const char*)(gbase) + (voff)[_i]), (PG8_LAS unsigned*)(lds + (bufoff) + ldsw + _i * 8192), 16, 0, 0); } while (0)
#define PG8_LDA(dst, b, h) do { _Pragma("unroll") for (int m = 0; m < 4; ++m) _Pragma("unroll") for (int k = 0; k < 2; ++k) dst[m][k] = *(const PG8_LAS bf16x8*)(lds + PG8_SA(b, h) + aoff + m * 2048 + k * 1024); } while (0)
#define PG8_LDB(dst, b, h) do { _Pragma("unroll") for (int n = 0; n < 2; ++n) _Pragma("unroll") for (int k = 0; k < 2; ++k) dst[n][k] = *(const PG8_LAS bf16x8*)(lds + PG8_SB(b, h) + boff + n * 2048 + k * 1024); } while (0)
#define PG8_MMA(ai, bj, At, Bt) do { __builtin_amdgcn_s_setprio(1); _Pragma("unroll") for (int m = 0; m < 4; ++m) _Pragma("unroll") for (int n = 0; n < 2; ++n) _Pragma("unroll") for (int k = 0; k < 2; ++k) \
        acc[ai][bj][m][n] = __builtin_amdgcn_mfma_f32_16x16x32_bf16(Bt[n][k], At[m][k], acc[ai][bj][m][n], 0, 0, 0); __builtin_amdgcn_s_setprio(0); } while (0)
#define PG8_WAIT_V(n) asm volatile("s_waitcnt vmcnt(" #n ")" ::: "memory")
#define PG8_WAIT_L(n) asm volatile("s_waitcnt lgkmcnt(" #n ")" ::: "memory")
#define PG8_BAR __builtin_amdgcn_s_barrier()
#define PG8_SCHED __builtin_amdgcn_sched_barrier(0)
    Unit cur, nxt; int ui = 0;
    if (!S.next(0, cur)) return;
    f32x4 acc[2][2][4][2];
#pragma unroll
    for (int a = 0; a < 2; ++a)
#pragma unroll
        for (int b = 0; b < 2; ++b)
#pragma unroll
            for (int m = 0; m < 4; ++m)
#pragma unroll
                for (int n = 0; n < 2; ++n) acc[a][b][m][n] = (f32x4){0.f, 0.f, 0.f, 0.f};
    bf16x8 At[4][2], B0[2][2], B1[2][2];
    const char* cA = S.a_ptr(g, cur, tstep); const char* cB = S.b_ptr(g, cur, tstep);
    S.a_ready(cur);
    if constexpr (SP2) {
        PG8_STAGE(PG8_SB(0, 0), cB, voffB); PG8_STAGE(PG8_SB(0, 1), cB + hstep, voffB); PG8_STAGE(PG8_SA(0, 0), cA, voffA); PG8_STAGE(PG8_SA(0, 1), cA + hstep, voffA);
        if (wr == 1) PG8_BAR;
        PG8_WAIT_V(2); PG8_BAR;
        PG8_STAGE(PG8_SB(1, 0), cB + kstep, voffB); PG8_STAGE(PG8_SA(1, 0), cA + kstep, voffA); PG8_STAGE(PG8_SB(1, 1), cB + hstep + kstep, voffB);
        PG8_WAIT_V(6); PG8_BAR;
    } else {
        PG8_STAGE(PG8_SB(0, 0), cB, voffB); PG8_STAGE(PG8_SA(0, 0), cA, voffA); PG8_STAGE(PG8_SB(0, 1), cB + hstep, voffB); PG8_STAGE(PG8_SA(0, 1), cA + hstep, voffA);
        if (wr == 1) PG8_BAR;
        PG8_WAIT_V(4); PG8_BAR;
        PG8_STAGE(PG8_SB(1, 0), cB + kstep, voffB); PG8_STAGE(PG8_SA(1, 0), cA + kstep, voffA); PG8_STAGE(PG8_SB(1, 1), cB + hstep + kstep, voffB);
        PG8_WAIT_V(6); PG8_BAR;
    }
    for (;;) {
        const bool has_next = S.next(ui + 1, nxt);
        const char* nA = has_next ? S.a_ptr(g, nxt, tstep) : cA; const char* nB = has_next ? S.b_ptr(g, nxt, tstep) : cB;
        for (int t = 0; t < nt; t += 2) {
            const bool last = (t == nt - 2);
            const char* a1 = cA + (size_t)(t + 1) * kstep;
            const char* a2 = last ? nA : cA + (size_t)(t + 2) * kstep; const char* b2 = last ? nB : cB + (size_t)(t + 2) * kstep;
            const char* a3 = a2 + kstep; const char* b3 = b2 + kstep;
            if (last && has_next) S.a_ready(nxt);
            if constexpr (SP2) {
            PG8_LDB(B0, 0, 0); PG8_LDB(B1, 0, 1); PG8_SCHED; PG8_LDA(At, 0, 0); PG8_STAGE(PG8_SA(1, 1), a1 + hstep, voffA);
            PG8_WAIT_V(8); PG8_WAIT_L(0); PG8_BAR; PG8_MMA(0, 0, At, B0); PG8_MMA(0, 1, At, B1); PG8_BAR; PG8_SCHED;
            PG8_LDA(At, 0, 1); PG8_STAGE(PG8_SB(0, 0), b2, voffB); PG8_STAGE(PG8_SB(0, 1), b2 + hstep, voffB); PG8_STAGE(PG8_SA(0, 0), a2, voffA);
            PG8_WAIT_V(8); PG8_WAIT_L(0); PG8_BAR; PG8_MMA(1, 0, At, B0); PG8_MMA(1, 1, At, B1); PG8_BAR; PG8_SCHED;
            PG8_LDB(B0, 1, 0); PG8_LDB(B1, 1, 1); PG8_SCHED; PG8_LDA(At, 1, 0); PG8_STAGE(PG8_SA(0, 1), a2 + hstep, voffA);
            PG8_WAIT_V(8); PG8_WAIT_L(0); PG8_BAR; PG8_MMA(0, 0, At, B0); PG8_MMA(0, 1, At, B1); PG8_BAR; PG8_SCHED;
            PG8_LDA(At, 1, 1); PG8_STAGE(PG8_SB(1, 0), b3, voffB); PG8_STAGE(PG8_SB(1, 1), b3 + hstep, voffB); PG8_STAGE(PG8_SA(1, 0), a3, voffA);
            PG8_WAIT_V(8); PG8_WAIT_L(0); PG8_BAR; PG8_MMA(1, 0, At, B0); PG8_MMA(1, 1, At, B1); PG8_BAR; PG8_SCHED;
            } else {
            PG8_LDB(B0, 0, 0); PG8_SCHED; PG8_LDA(At, 0, 0); PG8_STAGE(PG8_SA(1, 1), a1 + hstep, voffA);
            PG8_WAIT_L(8); PG8_BAR; PG8_WAIT_L(0); PG8_MMA(0, 0, At, B0); PG8_BAR; PG8_SCHED;
            PG8_LDB(B1, 0, 1); PG8_STAGE(PG8_SB(0, 0), b2, voffB);
            PG8_BAR; PG8_WAIT_L(0); PG8_MMA(0, 1, At, B1); PG8_BAR;
            PG8_LDA(At, 0, 1); PG8_STAGE(PG8_SA(0, 0), a2, voffA);
            PG8_BAR; PG8_WAIT_L(0); PG8_MMA(1, 0, At, B0); PG8_BAR; PG8_SCHED;
            PG8_STAGE(PG8_SB(0, 1), b2 + hstep, voffB);
            PG8_WAIT_V(6); PG8_BAR; PG8_MMA(1, 1, At, B1); PG8_BAR;
            PG8_LDB(B0, 1, 0); PG8_SCHED; PG8_LDA(At, 1, 0); PG8_STAGE(PG8_SA(0, 1), a2 + hstep, voffA);
            PG8_WAIT_L(8); PG8_BAR; PG8_WAIT_L(0); PG8_MMA(0, 0, At, B0); PG8_BAR; PG8_SCHED;
            PG8_LDB(B1, 1, 1); PG8_STAGE(PG8_SB(1, 0), b3, voffB);
            PG8_BAR; PG8_WAIT_L(0); PG8_MMA(0, 1, At, B1); PG8_BAR;
            PG8_LDA(At, 1, 1); PG8_STAGE(PG8_SA(1, 0), a3, voffA);
            PG8_BAR; PG8_WAIT_L(0); PG8_MMA(1, 0, At, B0); PG8_BAR; PG8_SCHED;
            PG8_STAGE(PG8_SB(1, 1), b3 + hstep, voffB);
            PG8_WAIT_V(6); PG8_BAR; PG8_MMA(1, 1, At, B1); PG8_BAR;
            }
        }
        if constexpr (ALIGN_EPI) { if (wr == 0) PG8_BAR; }
        if constexpr (!Epi::AFTER_DRAIN) { E(acc, cur, wr, wc, fr, fq); S.done(cur); }
        if (!has_next) break;
#pragma unroll
        for (int a = 0; a < 2; ++a)
#pragma unroll
            for (int b = 0; b < 2; ++b)
#pragma unroll
                for (int m = 0; m < 4; ++m)
#pragma unroll
                    for (int n = 0; n < 2; ++n) acc[a][b][m][n] = (f32x4){0.f, 0.f, 0.f, 0.f};
        cur = nxt; cA = nA; cB = nB; ++ui;
        if constexpr (ALIGN_EPI) { if (wr == 1) PG8_BAR; }
    }
    PG8_WAIT_V(0);
    if constexpr (!ALIGN_EPI) { if (wr == 0) PG8_BAR; }
    PG8_BAR;
    if constexpr (Epi::AFTER_DRAIN) { E.fused(acc, cur, wr, wc, fr, fq, lds, wid, lane); S.done(cur); }
#undef PG8_SA
#undef PG8_SB
#undef PG8_STAGE
#undef PG8_LDA
#undef PG8_LDB
#undef PG8_MMA
#undef PG8_WAIT_V
#undef PG8_WAIT_L
#undef PG8_BAR
#undef PG8_SCHED
}
}

constexpr int T = 16384, D = 2048, SEQ = 4096, NBATCH = 4, NH = 16, HD = 128;
constexpr int N_IN = 10240, FFN = 5504, NGU = 2 * FFN, NQKV = 3 * D, NE = 8, FE = 7168, NMGU = 2 * FE;
constexpr int P_MAX = 2 * T + NE * 256;
constexpr float EPS = 1e-6f;
constexpr int NWAVES = 8, NTHREADS = 512;

constexpr size_t MiB = 1u << 20;
constexpr size_t WS_CTL = 0, CTL_ZERO_BYTES = 1 * MiB;
constexpr size_t WS_W_IN  = 1 * MiB;
constexpr size_t WS_W_HO  = WS_W_IN  + (size_t)N_IN * D * 2;
constexpr size_t WS_W_GU  = WS_W_HO  + (size_t)D * D * 2;
constexpr size_t WS_W_DN  = WS_W_GU  + (size_t)NGU * D * 2;
constexpr size_t WS_W_QKV = WS_W_DN  + (size_t)D * FFN * 2;
constexpr size_t WS_W_AO  = WS_W_QKV + (size_t)NQKV * D * 2;
constexpr size_t WS_W_MGU = WS_W_AO  + (size_t)D * D * 2;
constexpr size_t WS_W_MDN = WS_W_MGU + (size_t)NE * NMGU * D * 2;
constexpr size_t WS_ARENA = WS_W_MDN + (size_t)NE * D * FE * 2;
constexpr size_t A_HN   = WS_ARENA;
constexpr size_t A_BIG  = A_HN + (size_t)T * D * 2;
constexpr size_t A_OF   = A_BIG + (size_t)T * N_IN * 2;
constexpr size_t A_LSE  = A_OF + (size_t)3 * T * D * 2;
constexpr size_t A_OB   = A_LSE + (size_t)3 * T * NH * 4;
constexpr size_t A_XG   = A_BIG;
constexpr size_t A_MH   = A_XG + (size_t)P_MAX * D * 2;
constexpr size_t A_REC  = (A_MH + (size_t)P_MAX * FE * 2 > A_OB + (size_t)T * D * 2) ? A_MH + (size_t)P_MAX * FE * 2 : A_OB + (size_t)T * D * 2;
constexpr size_t A_TSLOT = A_REC + (size_t)T * 32;
constexpr size_t WS_END = A_TSLOT + (size_t)T * 8;
static_assert(WS_END < (size_t)1750 * MiB, "workspace map too large");
constexpr int CW_BAR = 4096;
constexpr int CW_MOE = 2048;
constexpr int N_PHASES = 19;

constexpr int RING_BYTES = 131072;
constexpr int MISC_OFF = RING_BYTES;
constexpr int LDS_BYTES = 147456;

#define GAS __attribute__((address_space(1)))
#define LAS __attribute__((address_space(3)))
typedef unsigned short bf16;
typedef unsigned v4u __attribute__((ext_vector_type(4)));
typedef unsigned v2u __attribute__((ext_vector_type(2)));
typedef float f32x4 __attribute__((ext_vector_type(4)));
typedef short bf16x8 __attribute__((ext_vector_type(8)));
#define RLX_AGENT __ATOMIC_RELAXED, __HIP_MEMORY_SCOPE_AGENT
#define LDS_WAIT() asm volatile("s_waitcnt lgkmcnt(0)" ::: "memory")
__device__ __forceinline__ unsigned f2bf(float f) { unsigned u = __builtin_bit_cast(unsigned, f); return (u + 0x7fffu + ((u >> 16) & 1u)) >> 16; }
__device__ __forceinline__ unsigned pk2(float lo, float hi) { return f2bf(lo) | (f2bf(hi) << 16); }
__device__ __forceinline__ float bflo(unsigned w) { return __builtin_bit_cast(float, w << 16); }
__device__ __forceinline__ float bfhi(unsigned w) { return __builtin_bit_cast(float, w & 0xffff0000u); }
__device__ __forceinline__ float bf2f(bf16 h) { return __builtin_bit_cast(float, (unsigned)h << 16); }

#define XB_TMO      128
#define XB_XCNT(j)  (256  + 64 * (j))
#define XB_XSUB(j)  (1280 + 64 * (j))
#define XB_XGEN(j)  (2304 + 64 * (j))
#define XB_TOP      3328
#define XB_TOPGEN   3392
#define XCD_BAR_WORDS 3456
#define XB_SPIN_CAP (1u << 18)
__device__ __forceinline__ unsigned xb_ld(unsigned* p)              { return __hip_atomic_load(p, __ATOMIC_RELAXED, __HIP_MEMORY_SCOPE_AGENT); }
__device__ __forceinline__ unsigned xb_add(unsigned* p, unsigned v) { return __hip_atomic_fetch_add(p, v, __ATOMIC_RELAXED, __HIP_MEMORY_SCOPE_AGENT); }
__device__ __forceinline__ unsigned xb_xcc_id() { return (unsigned)__builtin_amdgcn_s_getreg((3 << 11) | 20) & 0xFu; }
#define XB_SPIN(cond, bar) do { unsigned _sp = 0; while (cond) { __builtin_amdgcn_s_sleep(1); \
    if ((++_sp & 255u) == 0u) { if (xb_ld(&(bar)[XB_TMO])) break; if (_sp > XB_SPIN_CAP) { atomicAdd(&(bar)[XB_TMO], 1u); break; } } } } while (0)
struct XcdBarrier { unsigned* bar; unsigned x; volatile LAS unsigned* st; };
__device__ __forceinline__ XcdBarrier xcd_barrier_post(unsigned* bar, volatile LAS unsigned* st) {
    XcdBarrier b; b.bar = bar; b.x = xb_xcc_id(); b.st = st;
    if (threadIdx.x == 0) (void)xb_add(&bar[XB_XCNT(b.x)], 1u);
    return b;
}
__device__ __forceinline__ void xcd_barrier_complete(unsigned* bar, unsigned x, unsigned& nloc, unsigned& nx) {
    const unsigned G = gridDim.x * gridDim.y * gridDim.z;
    unsigned sum, cnt, mine, sp = 0u;
    for (;;) {
        sum = 0u; cnt = 0u; mine = 0u;
#pragma unroll
        for (unsigned j = 0; j < 16; ++j) { const unsigned c = xb_ld(&bar[XB_XCNT(j)]); sum += c; cnt += (c > 0u) ? 1u : 0u; mine = (j == x) ? c : mine; }
        if (sum == G) break;
        __builtin_amdgcn_s_sleep(1);
        if ((++sp & 255u) == 0u) { if (xb_ld(&bar[XB_TMO])) break; if (sp > XB_SPIN_CAP) { atomicAdd(&bar[XB_TMO], 1u); break; } }
    }
    nloc = mine > 0u ? mine : 1u; nx = cnt > 0u ? cnt : 1u;
}
__device__ __forceinline__ void xcd_barrier(const XcdBarrier& b) {
    asm volatile("s_waitcnt vmcnt(0)" ::: "memory");
    __syncthreads();
    if (threadIdx.x == 0) {
        unsigned* bar = b.bar;
        __builtin_amdgcn_s_waitcnt(0);
        unsigned nloc = b.st[0], nx = b.st[1];
        if (nloc == 0u) { xcd_barrier_complete(bar, b.x, nloc, nx); b.st[0] = nloc; b.st[1] = nx; }
        const unsigned old = xb_add(&bar[XB_XSUB(b.x)], 1u);
        const unsigned gen = old / nloc;
        if (old + 1u == (gen + 1u) * nloc) {
            __builtin_amdgcn_fence(__ATOMIC_RELEASE, "agent");
            asm volatile("s_waitcnt vmcnt(0)" ::: "memory");
            const unsigned og = xb_add(&bar[XB_TOP], 1u);
            const unsigned tg = og / nx;
            if (og + 1u == (tg + 1u) * nx) xb_add(&bar[XB_TOPGEN], 1u);
            else XB_SPIN(xb_ld(&bar[XB_TOPGEN]) == tg, bar);
            __builtin_amdgcn_fence(__ATOMIC_ACQUIRE, "agent");
            xb_add(&bar[XB_XGEN(b.x)], 1u);
            asm volatile("s_waitcnt vmcnt(0)" ::: "memory");
        } else {
            XB_SPIN(xb_ld(&bar[XB_XGEN(b.x)]) == gen, bar);
            __builtin_amdgcn_fence(__ATOMIC_ACQUIRE, "agent");
            asm volatile("s_waitcnt vmcnt(0)" ::: "memory");
        }
    }
    __syncthreads();
}

struct Frame {
    LAS unsigned char* lds;
    unsigned* ctl;
    int tid, lane, wave, vcu, G;
    const float *x, *gains, *w_in, *lbl, *onorm, *w_ho, *w_qkv, *qgain, *kgain, *w_ao, *w_g, *w_u, *w_d, *w_r, *mw_g, *mw_u, *mw_d;
    float* out;
    bf16 *Wt_in, *Wt_ho, *Wt_gu, *Wt_dn, *Wt_qkv, *Wt_ao, *Wt_mgu, *Wt_mdn;
    bf16 *hn, *big, *of, *ob, *xg, *mh;
    float* lse; int* rec; int* tslot;
};
__device__ __forceinline__ float wave_sum(float v) {
#pragma unroll
    for (int o = 1; o < 64; o <<= 1) v += __shfl_xor(v, o);
    return v;
}

__device__ __forceinline__ void p0_transpose_item(const float* W, int K, int N, bf16* WT, LAS float* scr, int item, int lane, int mode) {
    const int nblk = N / 32, kb = item / nblk, nb = item % nblk, k0 = 64 * kb, n0 = 32 * nb;
    const int orow0 = mode == 0 ? n0 : (((n0 >> 7) << 8) + (mode == 2 ? 128 : 0) + (n0 & 127));
#pragma unroll 8
    for (int i = 0; i < 32; ++i) { const int kk = 2 * i + (lane >> 5); scr[kk * 33 + (lane & 31)] = W[(size_t)(k0 + kk) * N + n0 + (lane & 31)]; }
    LDS_WAIT(); asm volatile("" ::: "memory");
    const int c = lane & 7;
#pragma unroll
    for (int j = 0; j < 4; ++j) { const int n = (lane >> 3) + 8 * j; const LAS float* s = scr + (8 * c) * 33 + n;
        v4u o; o.x = pk2(s[0 * 33], s[1 * 33]); o.y = pk2(s[2 * 33], s[3 * 33]); o.z = pk2(s[4 * 33], s[5 * 33]); o.w = pk2(s[6 * 33], s[7 * 33]);
        *(GAS v4u*)(WT + (size_t)(orow0 + n) * K + k0 + 8 * c) = o; }
    LDS_WAIT(); asm volatile("" ::: "memory");
}
__device__ __forceinline__ void rms_row_to_bf16(const float* xrow, const float* gain, bf16* orow, int lane) {
    const GAS f32x4* xr = (const GAS f32x4*)xrow + lane; const GAS f32x4* gr = (const GAS f32x4*)gain + lane;
    f32x4 v[8]; float s = 0.f;
#pragma unroll
    for (int j = 0; j < 8; ++j) { v[j] = xr[64 * j]; s += (v[j].x * v[j].x + v[j].y * v[j].y) + (v[j].z * v[j].z + v[j].w * v[j].w); }
    const float r = 1.0f / sqrtf(wave_sum(s) * (1.f / D) + EPS);
    GAS v2u* o8 = (GAS v2u*)orow + lane;
#pragma unroll
    for (int j = 0; j < 8; ++j) { const f32x4 g = gr[64 * j]; v2u w; w.x = pk2(v[j].x * r * g.x, v[j].y * r * g.y); w.y = pk2(v[j].z * r * g.z, v[j].w * r * g.w); o8[64 * j] = w; }
}
__device__ __forceinline__ void rms_phase(Frame& F, const float* x, const float* gain, bf16* hn) {
    const int gw = F.vcu * NWAVES + F.wave, NGW = F.G * NWAVES;
    for (int m = gw; m < T; m += NGW) rms_row_to_bf16(x + (size_t)m * D, gain, hn + (size_t)m * D, F.lane);
}
__device__ __forceinline__ void p0_prologue(Frame& F) {
    LAS float* scr = (LAS float*)(F.lds + F.wave * 16384);
    const int gw = F.vcu * NWAVES + F.wave, NGW = F.G * NWAVES;
    constexpr int I_IN = (D / 64) * (N_IN / 32), I_SQ = (D / 64) * (D / 32), I_G = (D / 64) * (FFN / 32), I_DN = (FFN / 64) * (D / 32), I_QKV = (D / 64) * (NQKV / 32);
    constexpr int I_MG = (D / 64) * (FE / 32), I_MD = (FE / 64) * (D / 32);
    constexpr int NITEMS = I_IN + 2 * I_SQ + 2 * I_G + I_DN + I_QKV + NE * (2 * I_MG + I_MD);
    for (int it = gw; it < NITEMS; it += NGW) {
        int r = it;
        if (r < I_IN) { p0_transpose_item(F.w_in, D, N_IN, F.Wt_in, scr, r, F.lane, 0); continue; } r -= I_IN;
        if (r < I_SQ) { p0_transpose_item(F.w_ho, D, D, F.Wt_ho, scr, r, F.lane, 0); continue; } r -= I_SQ;
        if (r < I_G) { p0_transpose_item(F.w_g, D, FFN, F.Wt_gu, scr, r, F.lane, 1); continue; } r -= I_G;
        if (r < I_G) { p0_transpose_item(F.w_u, D, FFN, F.Wt_gu, scr, r, F.lane, 2); continue; } r -= I_G;
        if (r < I_DN) { p0_transpose_item(F.w_d, FFN, D, F.Wt_dn, scr, r, F.lane, 0); continue; } r -= I_DN;
        if (r < I_QKV) { p0_transpose_item(F.w_qkv, D, NQKV, F.Wt_qkv, scr, r, F.lane, 0); continue; } r -= I_QKV;
        if (r < I_SQ) { p0_transpose_item(F.w_ao, D, D, F.Wt_ao, scr, r, F.lane, 0); continue; } r -= I_SQ;
        if (r < NE * I_MG) { const int e = r / I_MG; p0_transpose_item(F.mw_g + (size_t)e * D * FE, D, FE, F.Wt_mgu + (size_t)e * NMGU * D, scr, r % I_MG, F.lane, 1); continue; } r -= NE * I_MG;
        if (r < NE * I_MG) { const int e = r / I_MG; p0_transpose_item(F.mw_u + (size_t)e * D * FE, D, FE, F.Wt_mgu + (size_t)e * NMGU * D, scr, r % I_MG, F.lane, 2); continue; } r -= NE * I_MG;
        { const int e = r / I_MD; p0_transpose_item(F.mw_d + (size_t)e * FE * D, FE, D, F.Wt_mdn + (size_t)e * D * FE, scr, r % I_MD, F.lane, 0); }
    }
    rms_phase(F, F.x, F.gains, F.hn);
}

__device__ __forceinline__ void scan_phase(Frame& F) {
    LAS float* sQ = (LAS float*)F.lds;
    LAS float* sF = sQ + 64 * 128;
    LAS float* sV = sF + 64 * 128;
    LAS float* sO = sV + 64 * 64;
    const int tid = F.tid, lane = F.lane, w = F.wave, kg = lane >> 3, vi = lane & 7;
    const int cg = tid & 15, r0 = tid >> 4, vr = tid >> 3, vc = tid & 7;
    const bf16* proj = F.big;
    for (int unit = blockIdx.x; unit < 256; unit += F.G) {
        const int half = unit & 1, dir = (unit >> 1) & 1, h = (unit >> 2) & 15, b = unit >> 6;
        float lbv[8];
#pragma unroll
        for (int j = 0; j < 8; ++j) { const int col = h * 128 + cg * 8 + j;
            const float l0 = F.lbl[(0 * 2 + dir) * 2048 + col], l1 = F.lbl[(1 * 2 + dir) * 2048 + col], l2 = F.lbl[(2 * 2 + dir) * 2048 + col];
            const float mx = fmaxf(l0, fmaxf(l1, l2)); const float e0 = expf(l0 - mx), e1 = expf(l1 - mx), e2 = expf(l2 - mx); lbv[j] = e0 / (e0 + e1 + e2); }
        const bf16* pb = proj + (size_t)(b * SEQ) * N_IN;
        const int qcol = h * 128 + cg * 8, fcol = 2048 * (1 + dir) + h * 128 + cg * 8, vcol = 6144 + h * 128 + half * 64 + vc * 8;
        bf16* obase = F.of + (size_t)dir * T * D + (size_t)(b * SEQ) * D + h * 128 + half * 64 + vc * 8;
        float S[16];
#pragma unroll
        for (int i = 0; i < 16; ++i) S[i] = 0.f;
        v4u rq[2], rf[2], rv;
#define SCAN_TOK(c, tt) (dir ? (SEQ - 1 - ((c) * 64 + (tt))) : ((c) * 64 + (tt)))
#define SCAN_LOAD(c) do { _Pragma("unroll") for (int i = 0; i < 2; ++i) { const size_t ro = (size_t)SCAN_TOK(c, r0 + 32 * i) * N_IN; rq[i] = *(const GAS v4u*)(pb + ro + qcol); rf[i] = *(const GAS v4u*)(pb + ro + fcol); } \
        rv = *(const GAS v4u*)(pb + (size_t)SCAN_TOK(c, vr) * N_IN + vcol); } while (0)
        SCAN_LOAD(0);
        for (int c = 0; c < 64; ++c) {
            if (c > 0) { __syncthreads();
                const LAS f32x4* so = (const LAS f32x4*)(sO + vr * 64 + vc * 8); const f32x4 a = so[0], bq = so[1];
                v4u o; o.x = pk2(a.x, a.y); o.y = pk2(a.z, a.w); o.z = pk2(bq.x, bq.y); o.w = pk2(bq.z, bq.w);
                *(GAS v4u*)(obase + (size_t)SCAN_TOK(c - 1, vr) * D) = o; }
#pragma unroll
            for (int i = 0; i < 2; ++i) {
                const unsigned qw[4] = {rq[i].x, rq[i].y, rq[i].z, rq[i].w}, fw[4] = {rf[i].x, rf[i].y, rf[i].z, rf[i].w};
                float qs[8], fs[8];
#pragma unroll
                for (int j = 0; j < 4; ++j) { const float q0 = bflo(qw[j]), q1 = bfhi(qw[j]), f0 = bflo(fw[j]), f1 = bfhi(fw[j]);
                    qs[2 * j] = q0 * __builtin_amdgcn_rcpf(1.0f + __expf(-q0)); qs[2 * j + 1] = q1 * __builtin_amdgcn_rcpf(1.0f + __expf(-q1));
                    const float s0 = __builtin_amdgcn_rcpf(1.0f + __expf(-f0)), s1 = __builtin_amdgcn_rcpf(1.0f + __expf(-f1));
                    fs[2 * j] = lbv[2 * j] + (1.0f - lbv[2 * j]) * s0; fs[2 * j + 1] = lbv[2 * j + 1] + (1.0f - lbv[2 * j + 1]) * s1; }
                LAS f32x4* dq = (LAS f32x4*)(sQ + (r0 + 32 * i) * 128 + cg * 8); LAS f32x4* df = (LAS f32x4*)(sF + (r0 + 32 * i) * 128 + cg * 8);
                dq[0] = (f32x4){qs[0], qs[1], qs[2], qs[3]}; dq[1] = (f32x4){qs[4], qs[5], qs[6], qs[7]};
                df[0] = (f32x4){fs[0], fs[1], fs[2], fs[3]}; df[1] = (f32x4){fs[4], fs[5], fs[6], fs[7]};
            }
            { LAS f32x4* dv = (LAS f32x4*)(sV + vr * 64 + vc * 8);
              dv[0] = (f32x4){bflo(rv.x), bfhi(rv.x), bflo(rv.y), bfhi(rv.y)}; dv[1] = (f32x4){bflo(rv.z), bfhi(rv.z), bflo(rv.w), bfhi(rv.w)}; }
            if (c + 1 < 64) SCAN_LOAD(c + 1);
            __syncthreads();
#pragma unroll 2
            for (int tt = 0; tt < 64; ++tt) {
                const LAS f32x4* q4 = (const LAS f32x4*)(sQ + tt * 128 + kg * 16); const LAS f32x4* f4 = (const LAS f32x4*)(sF + tt * 128 + kg * 16);
                const float v = sV[tt * 64 + w * 8 + vi];
                float o0 = 0.f, o1 = 0.f, o2 = 0.f, o3 = 0.f;
#pragma unroll
                for (int i = 0; i < 4; ++i) { const f32x4 qv = q4[i], fv = f4[i];
                    S[4 * i + 0] = fmaf(fv.x, S[4 * i + 0] - v, v); o0 = fmaf(qv.x, S[4 * i + 0], o0);
                    S[4 * i + 1] = fmaf(fv.y, S[4 * i + 1] - v, v); o1 = fmaf(qv.y, S[4 * i + 1], o1);
                    S[4 * i + 2] = fmaf(fv.z, S[4 * i + 2] - v, v); o2 = fmaf(qv.z, S[4 * i + 2], o2);
                    S[4 * i + 3] = fmaf(fv.w, S[4 * i + 3] - v, v); o3 = fmaf(qv.w, S[4 * i + 3], o3); }
                float o = (o0 + o1) + (o2 + o3);
                o += __shfl_xor(o, 8); o += __shfl_xor(o, 16); o += __shfl_xor(o, 32);
                if (kg == 0) sO[tt * 64 + w * 8 + vi] = o;
            }
        }
        __syncthreads();
        { const LAS f32x4* so = (const LAS f32x4*)(sO + vr * 64 + vc * 8); const f32x4 a = so[0], bq = so[1];
          v4u o; o.x = pk2(a.x, a.y); o.y = pk2(a.z, a.w); o.z = pk2(bq.x, bq.y); o.w = pk2(bq.z, bq.w);
          *(GAS v4u*)(obase + (size_t)SCAN_TOK(63, vr) * D) = o; }
        __syncthreads();
#undef SCAN_TOK
#undef SCAN_LOAD
    }
}

__device__ __forceinline__ void onorm_phase(Frame& F) {
    const int gw = F.vcu * NWAVES + F.wave, NGW = F.G * NWAVES, lane = F.lane;
    const bf16* proj = F.big;
    for (int m = gw; m < T; m += NGW) {
#pragma unroll
        for (int pass = 0; pass < 4; ++pass) {
            const int c0 = (pass * 64 + lane) * 8;
            const v4u a = *(const GAS v4u*)(F.of + (size_t)m * D + c0), bq = *(const GAS v4u*)(F.of + (size_t)T * D + (size_t)m * D + c0);
            const v4u gt = *(const GAS v4u*)(proj + (size_t)m * N_IN + 8192 + c0);
            const f32x4 g0 = *(const GAS f32x4*)(F.onorm + c0), g1 = *(const GAS f32x4*)(F.onorm + c0 + 4);
            const unsigned aw[4] = {a.x, a.y, a.z, a.w}, bw[4] = {bq.x, bq.y, bq.z, bq.w}, gw4[4] = {gt.x, gt.y, gt.z, gt.w};
            const float gn[8] = {g0.x, g0.y, g0.z, g0.w, g1.x, g1.y, g1.z, g1.w};
            float o[8], ss = 0.f;
#pragma unroll
            for (int j = 0; j < 4; ++j) { o[2 * j] = bflo(aw[j]) + bflo(bw[j]); o[2 * j + 1] = bfhi(aw[j]) + bfhi(bw[j]); ss += o[2 * j] * o[2 * j] + o[2 * j + 1] * o[2 * j + 1]; }
            ss += __shfl_xor(ss, 1); ss += __shfl_xor(ss, 2); ss += __shfl_xor(ss, 4); ss += __shfl_xor(ss, 8);
            const float r = 1.0f / sqrtf(ss * (1.f / 128.f) + EPS);
            float y[8];
#pragma unroll
            for (int j = 0; j < 4; ++j) { const float t0 = bflo(gw4[j]), t1 = bfhi(gw4[j]);
                y[2 * j] = o[2 * j] * r * gn[2 * j] * (t0 * __builtin_amdgcn_rcpf(1.0f + __expf(-t0)));
                y[2 * j + 1] = o[2 * j + 1] * r * gn[2 * j + 1] * (t1 * __builtin_amdgcn_rcpf(1.0f + __expf(-t1))); }
            v4u w; w.x = pk2(y[0], y[1]); w.y = pk2(y[2], y[3]); w.z = pk2(y[4], y[5]); w.w = pk2(y[6], y[7]);
            *(GAS v4u*)(F.ob + (size_t)m * D + c0) = w;
        }
    }
}

__device__ __forceinline__ void qknorm_rope_phase(Frame& F) {
    const int gw = F.vcu * NWAVES + F.wave, NGW = F.G * NWAVES, lane = F.lane;
    bf16* qkv = F.big;
    const float inv = expf(-(float)lane * (2.0f / 128.0f) * 9.210340371976184f);
    const float qg1 = F.qgain[lane], qg2 = F.qgain[lane + 64], kg1 = F.kgain[lane], kg2 = F.kgain[lane + 64];
    for (int m = gw; m < T; m += NGW) {
        const float pos = (float)(m & (SEQ - 1));
        float rev = pos * inv * 0.15915494309189535f; rev -= floorf(rev);
        const float sn = __builtin_amdgcn_sinf(rev), cs = __builtin_amdgcn_cosf(rev);
#pragma unroll 4
        for (int vec = 0; vec < 32; ++vec) {
            const bool isq = vec < 16; bf16* base = qkv + (size_t)m * NQKV + (isq ? 0 : 2048) + (vec & 15) * 128;
            const float x1 = bf2f(base[lane]), x2 = bf2f(base[lane + 64]);
            const float ss = wave_sum(x1 * x1 + x2 * x2);
            const float r = 1.0f / sqrtf(ss * (1.f / 128.f) + EPS);
            const float y1 = x1 * r * (isq ? qg1 : kg1), y2 = x2 * r * (isq ? qg2 : kg2);
            float o1 = y1 * cs - y2 * sn, o2 = y2 * cs + y1 * sn;
            if (isq) { o1 *= 0.08838834764831845f; o2 *= 0.08838834764831845f; }
            base[lane] = (bf16)f2bf(o1); base[lane + 64] = (bf16)f2bf(o2);
        }
    }
}

constexpr int ATT_KP = 272;
constexpr int ATT_GRP_BYTES = 2 * 64 * ATT_KP;
__device__ __forceinline__ void attn_phase(Frame& F) {
    const int tid = F.tid, lane = F.lane, w = F.wave, gsel = w >> 2, qi = w & 3, gtid = tid & 255;
    const int l15 = lane & 15, g = lane >> 4;
    LAS unsigned char* Kl = F.lds + gsel * ATT_GRP_BYTES; LAS unsigned char* Vl = Kl + 64 * ATT_KP;
    const bf16* qkv = F.big;
    bf16* obr = F.of; float* lse = F.lse;
    constexpr int NPAIR = 64 * 3 * 64 / 2;
    const int per = (NPAIR + F.G - 1) / F.G, p_lo = F.vcu * per, p_hi = (p_lo + per < NPAIR) ? p_lo + per : NPAIR;
    const int nit = (p_hi > p_lo) ? (p_hi - p_lo) * 3 : 0;
    v4u R[8];
    int b = 0, h = 0, br = 0, r = 1, n = SEQ, cls = 0, nb = 0;
    bf16x8 Qf[4]; f32x4 Ot[8]; float mrow = -1e30f, lrow = 0.f;
#define ATT_UNIT(it_) do { const int uid = 2 * (p_lo + (it_) / 3) + gsel; const int bh = uid / 192, rem = uid % 192; br = rem / 64; const int idx = rem % 64; \
        b = bh >> 4; h = bh & 15; r = (br == 0) ? 1 : ((br == 1) ? 4 : 16); n = SEQ / r; const int nbk = 64 / r; cls = idx / nbk; nb = idx % nbk; } while (0)
#define ATT_PREFETCH(it_) do { int b_, h_, r_, n_, cls_, nb_; { const int uid = 2 * (p_lo + (it_) / 3) + gsel; const int bh = uid / 192, rem = uid % 192; const int br_ = rem / 64, idx = rem % 64; \
            b_ = bh >> 4; h_ = bh & 15; r_ = (br_ == 0) ? 1 : ((br_ == 1) ? 4 : 16); n_ = SEQ / r_; const int nbk = 64 / r_; cls_ = idx / nbk; nb_ = idx % nbk; } \
        const int kp0 = 64 * (nb_ - 1 + (it_) % 3); \
        _Pragma("unroll") for (int i = 0; i < 4; ++i) { const int idx = gtid + 256 * i, row = idx >> 4, ch = idx & 15; int kp = kp0 + row; kp = kp < 0 ? 0 : (kp >= n_ ? n_ - 1 : kp); \
            const bf16* src = qkv + (size_t)(b_ * SEQ + cls_ + r_ * kp) * NQKV + 2048 + h_ * 128 + ch * 8; R[i] = *(const GAS v4u*)src; R[4 + i] = *(const GAS v4u*)(src + 2048); } } while (0)
    if (nit > 0) ATT_PREFETCH(0);
    for (int it = 0; it < nit; ++it) {
        const int kb = it % 3;
        __syncthreads();
#pragma unroll
        for (int i = 0; i < 4; ++i) { const int idx = gtid + 256 * i, row = idx >> 4, ch = idx & 15; *(LAS v4u*)(Kl + row * ATT_KP + ch * 16) = R[i]; *(LAS v4u*)(Vl + row * ATT_KP + ch * 16) = R[4 + i]; }
        if (it + 1 < nit) ATT_PREFETCH(it + 1);
        __syncthreads();
        if (kb == 0) {
            ATT_UNIT(it);
            const int pq = 64 * nb + 16 * qi + l15; const bf16* qsrc = qkv + (size_t)(b * SEQ + cls + r * pq) * NQKV + h * 128 + 8 * g;
#pragma unroll
            for (int s = 0; s < 4; ++s) Qf[s] = *(const GAS bf16x8*)(qsrc + 32 * s);
#pragma unroll
            for (int c = 0; c < 8; ++c) Ot[c] = (f32x4){0.f, 0.f, 0.f, 0.f};
            mrow = -1e30f; lrow = 0.f;
        }
        const int pq = 64 * nb + 16 * qi + l15, kp0 = 64 * (nb - 1 + kb);
        f32x4 sc[4];
#pragma unroll
        for (int kt = 0; kt < 4; ++kt) { sc[kt] = (f32x4){0.f, 0.f, 0.f, 0.f};
#pragma unroll
            for (int s = 0; s < 4; ++s) { const bf16x8 kf = *(const LAS bf16x8*)(Kl + (16 * kt + l15) * ATT_KP + (32 * s + 8 * g) * 2);
                sc[kt] = __builtin_amdgcn_mfma_f32_16x16x32_bf16(kf, Qf[s], sc[kt], 0, 0, 0); } }
        float mx = -1e30f; bool valid[4][4];
#pragma unroll
        for (int kt = 0; kt < 4; ++kt)
#pragma unroll
            for (int e = 0; e < 4; ++e) { const int kp = kp0 + 16 * kt + 4 * g + e; const int d = kp - pq; valid[kt][e] = (kp >= 0) && (kp < n) && (d <= 64) && (d >= -64); if (valid[kt][e]) mx = fmaxf(mx, sc[kt][e]); }
        mx = fmaxf(mx, __shfl_xor(mx, 16)); mx = fmaxf(mx, __shfl_xor(mx, 32));
        const float mnew = fmaxf(mrow, mx), alpha = __expf(mrow - mnew);
        float rs = 0.f; float p[4][4];
#pragma unroll
        for (int kt = 0; kt < 4; ++kt)
#pragma unroll
            for (int e = 0; e < 4; ++e) { p[kt][e] = valid[kt][e] ? __expf(sc[kt][e] - mnew) : 0.f; rs += p[kt][e]; }
        rs += __shfl_xor(rs, 16); rs += __shfl_xor(rs, 32);
        lrow = lrow * alpha + rs; mrow = mnew;
#pragma unroll
        for (int c = 0; c < 8; ++c) Ot[c] = Ot[c] * alpha;
#pragma unroll
        for (int ks = 0; ks < 2; ++ks) {
            union { bf16x8 v; unsigned u[4]; } pf;
            pf.u[0] = pk2(p[2 * ks][0], p[2 * ks][1]); pf.u[1] = pk2(p[2 * ks][2], p[2 * ks][3]); pf.u[2] = pk2(p[2 * ks + 1][0], p[2 * ks + 1][1]); pf.u[3] = pk2(p[2 * ks + 1][2], p[2 * ks + 1][3]);
            const unsigned q4 = (unsigned)l15 >> 2, p4 = (unsigned)lane & 3u;
            const unsigned va = (unsigned)(size_t)Vl + (32u * ks + 4u * g + q4) * ATT_KP + p4 * 8u;
            v2u t0[8], t1[8];
            asm volatile(
                "ds_read_b64_tr_b16 %0, %16 offset:0\n\tds_read_b64_tr_b16 %1, %16 offset:32\n\tds_read_b64_tr_b16 %2, %16 offset:64\n\tds_read_b64_tr_b16 %3, %16 offset:96\n\t"
                "ds_read_b64_tr_b16 %4, %16 offset:128\n\tds_read_b64_tr_b16 %5, %16 offset:160\n\tds_read_b64_tr_b16 %6, %16 offset:192\n\tds_read_b64_tr_b16 %7, %16 offset:224\n\t"
                "ds_read_b64_tr_b16 %8, %17 offset:0\n\tds_read_b64_tr_b16 %9, %17 offset:32\n\tds_read_b64_tr_b16 %10, %17 offset:64\n\tds_read_b64_tr_b16 %11, %17 offset:96\n\t"
                "ds_read_b64_tr_b16 %12, %17 offset:128\n\tds_read_b64_tr_b16 %13, %17 offset:160\n\tds_read_b64_tr_b16 %14, %17 offset:192\n\tds_read_b64_tr_b16 %15, %17 offset:224\n\t"
                "s_waitcnt lgkmcnt(0)"
                : "=&v"(t0[0]), "=&v"(t0[1]), "=&v"(t0[2]), "=&v"(t0[3]), "=&v"(t0[4]), "=&v"(t0[5]), "=&v"(t0[6]), "=&v"(t0[7]),
                  "=&v"(t1[0]), "=&v"(t1[1]), "=&v"(t1[2]), "=&v"(t1[3]), "=&v"(t1[4]), "=&v"(t1[5]), "=&v"(t1[6]), "=&v"(t1[7])
                : "v"(va), "v"(va + 16u * ATT_KP) : "memory");
#pragma unroll
            for (int c = 0; c < 8; ++c) { union { bf16x8 v; unsigned u[4]; } vf; vf.u[0] = t0[c].x; vf.u[1] = t0[c].y; vf.u[2] = t1[c].x; vf.u[3] = t1[c].y;
                Ot[c] = __builtin_amdgcn_mfma_f32_16x16x32_bf16(vf.v, pf.v, Ot[c], 0, 0, 0); }
        }
        if (kb == 2) {
            const float il = 1.0f / lrow; const size_t mrowi = (size_t)(b * SEQ + cls + r * pq);
            bf16* op = obr + (size_t)br * T * D + mrowi * D + h * 128 + 4 * g;
#pragma unroll
            for (int c = 0; c < 8; ++c) { v2u wv; wv.x = pk2(Ot[c][0] * il, Ot[c][1] * il); wv.y = pk2(Ot[c][2] * il, Ot[c][3] * il); *(GAS v2u*)(op + 16 * c) = wv; }
            if (g == 0) lse[(size_t)br * T * NH + mrowi * NH + h] = mrow + __logf(lrow);
        }
    }
#undef ATT_UNIT
#undef ATT_PREFETCH
}
__device__ __forceinline__ void attn_combine_phase(Frame& F) {
    const int gw = F.vcu * NWAVES + F.wave, NGW = F.G * NWAVES, lane = F.lane;
    for (int m = gw; m < T; m += NGW) {
#pragma unroll
        for (int pass = 0; pass < 4; ++pass) {
            const int c0 = (pass * 64 + lane) * 8, hh = c0 >> 7;
            const float l0 = F.lse[(size_t)m * NH + hh], l1 = F.lse[(size_t)T * NH + (size_t)m * NH + hh], l2 = F.lse[(size_t)2 * T * NH + (size_t)m * NH + hh];
            const float mx = fmaxf(l0, fmaxf(l1, l2)); const float e0 = __expf(l0 - mx), e1 = __expf(l1 - mx), e2 = __expf(l2 - mx); const float is = 1.0f / (e0 + e1 + e2);
            const float w0 = e0 * is, w1 = e1 * is, w2 = e2 * is;
            const v4u a = *(const GAS v4u*)(F.of + (size_t)m * D + c0), bq = *(const GAS v4u*)(F.of + (size_t)T * D + (size_t)m * D + c0), cq = *(const GAS v4u*)(F.of + (size_t)2 * T * D + (size_t)m * D + c0);
            const unsigned aw[4] = {a.x, a.y, a.z, a.w}, bw[4] = {bq.x, bq.y, bq.z, bq.w}, cw[4] = {cq.x, cq.y, cq.z, cq.w};
            unsigned o[4];
#pragma unroll
            for (int j = 0; j < 4; ++j) o[j] = pk2(w0 * bflo(aw[j]) + w1 * bflo(bw[j]) + w2 * bflo(cw[j]), w0 * bfhi(aw[j]) + w1 * bfhi(bw[j]) + w2 * bfhi(cw[j]));
            *(GAS v4u*)(F.ob + (size_t)m * D + c0) = (v4u){o[0], o[1], o[2], o[3]};
        }
    }
}

__device__ __forceinline__ void router_phase(Frame& F) {
    const int tid = F.tid, lane = F.lane, w = F.wave;
    LAS int* sE = (LAS int*)F.lds;
    LAS float* sG = (LAS float*)(F.lds + 512);
    LAS int* lcnt = (LAS int*)(F.lds + 1024);
    LAS int* gbase = (LAS int*)(F.lds + 1088);
    const float* gain = F.gains + 3 * D;
    for (int blk = blockIdx.x; blk < T / 64; blk += F.G) {
        if (tid < 8) lcnt[tid] = 0;
        for (int i = 0; i < 8; ++i) {
            const int ti = w * 8 + i, m = blk * 64 + ti;
            const GAS f32x4* xr = (const GAS f32x4*)(F.out + (size_t)m * D) + lane; const GAS f32x4* gr = (const GAS f32x4*)gain + lane;
            f32x4 v[8]; float s = 0.f;
#pragma unroll
            for (int j = 0; j < 8; ++j) { v[j] = xr[64 * j]; s += (v[j].x * v[j].x + v[j].y * v[j].y) + (v[j].z * v[j].z + v[j].w * v[j].w); }
            const float r = 1.0f / sqrtf(wave_sum(s) * (1.f / D) + EPS);
            float lg[8];
#pragma unroll
            for (int e = 0; e < 8; ++e) lg[e] = 0.f;
            GAS v2u* o8 = (GAS v2u*)(F.hn + (size_t)m * D) + lane;
#pragma unroll
            for (int j = 0; j < 8; ++j) { const f32x4 g = gr[64 * j]; const float y[4] = {v[j].x * r * g.x, v[j].y * r * g.y, v[j].z * r * g.z, v[j].w * r * g.w};
                v2u wv; wv.x = pk2(y[0], y[1]); wv.y = pk2(y[2], y[3]); o8[64 * j] = wv;
                const GAS f32x4* wr4 = (const GAS f32x4*)(F.w_r + (size_t)(4 * (lane + 64 * j)) * NE);
#pragma unroll
                for (int q = 0; q < 4; ++q) { const f32x4 wa = wr4[2 * q], wb = wr4[2 * q + 1];
                    lg[0] = fmaf(y[q], wa.x, lg[0]); lg[1] = fmaf(y[q], wa.y, lg[1]); lg[2] = fmaf(y[q], wa.z, lg[2]); lg[3] = fmaf(y[q], wa.w, lg[3]);
                    lg[4] = fmaf(y[q], wb.x, lg[4]); lg[5] = fmaf(y[q], wb.y, lg[5]); lg[6] = fmaf(y[q], wb.z, lg[6]); lg[7] = fmaf(y[q], wb.w, lg[7]); } }
#pragma unroll
            for (int e = 0; e < 8; ++e) lg[e] = wave_sum(lg[e]);
            int e0 = 0; float b0 = lg[0];
#pragma unroll
            for (int e = 1; e < 8; ++e) if (lg[e] > b0) { b0 = lg[e]; e0 = e; }
            int e1 = -1; float b1 = -3.0e38f;
#pragma unroll
            for (int e = 0; e < 8; ++e) if (e != e0 && lg[e] > b1) { b1 = lg[e]; e1 = e; }
            const float g1 = 1.0f / (1.0f + __expf(b0 - b1)), g0 = 1.0f - g1;
            if (lane == 0) { sE[2 * ti] = e0; sE[2 * ti + 1] = e1; sG[2 * ti] = g0; sG[2 * ti + 1] = g1; }
        }
        __syncthreads();
        int e0 = 0, e1 = 0, r0 = 0, r1 = 0;
        if (tid < 64) { e0 = sE[2 * tid]; e1 = sE[2 * tid + 1]; r0 = atomicAdd((int*)&lcnt[e0], 1); r1 = atomicAdd((int*)&lcnt[e1], 1); }
        __syncthreads();
        if (tid < 8) gbase[tid] = (int)__hip_atomic_fetch_add(F.ctl + CW_MOE + 64 * tid, (unsigned)lcnt[tid], RLX_AGENT);
        __syncthreads();
        if (tid < 64) { const int m = blk * 64 + tid; int* rc = F.rec + (size_t)m * 8;
            rc[0] = e0; rc[1] = gbase[e0] + r0; rc[2] = e1; rc[3] = gbase[e1] + r1; rc[4] = __builtin_bit_cast(int, sG[2 * tid]); rc[5] = __builtin_bit_cast(int, sG[2 * tid + 1]); }
        __syncthreads();
    }
}
__device__ __forceinline__ void moe_tiles(Frame& F, int (&cnt)[8], int (&ct)[9]) {
    ct[0] = 0;
#pragma unroll
    for (int e = 0; e < 8; ++e) { cnt[e] = (int)__hip_atomic_load(F.ctl + CW_MOE + 64 * e, RLX_AGENT); ct[e + 1] = ct[e] + ((cnt[e] + 255) >> 8); }
}
__device__ __forceinline__ void gather_phase(Frame& F) {
    const int gw = F.vcu * NWAVES + F.wave, NGW = F.G * NWAVES, lane = F.lane;
    int cnt[8], ct[9]; moe_tiles(F, cnt, ct);
    for (int m = gw; m < T; m += NGW) {
        const int* rc = F.rec + (size_t)m * 8;
        const int e0 = rc[0], r0 = rc[1], e1 = rc[2], r1 = rc[3];
        int o0 = 0, o1 = 0;
#pragma unroll
        for (int e = 0; e < 8; ++e) { if (e == e0) o0 = ct[e]; if (e == e1) o1 = ct[e]; }
        const int s0 = o0 * 256 + r0, s1 = o1 * 256 + r1;
        const GAS v4u* src = (const GAS v4u*)(F.hn + (size_t)m * D) + lane;
        GAS v4u* d0 = (GAS v4u*)(F.xg + (size_t)s0 * D) + lane; GAS v4u* d1 = (GAS v4u*)(F.xg + (size_t)s1 * D) + lane;
#pragma unroll
        for (int j = 0; j < 4; ++j) { const v4u v = src[64 * j]; d0[64 * j] = v; d1[64 * j] = v; }
        if (lane == 0) { F.tslot[2 * m] = s0; F.tslot[2 * m + 1] = s1; }
    }
    for (int i = gw; i < 8 * 256; i += NGW) {
        const int e = i >> 8, j = i & 255; int c = 0, o = 0, nt = 0;
#pragma unroll
        for (int q = 0; q < 8; ++q) if (q == e) { c = cnt[q]; o = ct[q]; nt = ct[q + 1] - ct[q]; }
        const int row = o * 256 + c + j;
        if (c + j < nt * 256) { GAS v4u* d = (GAS v4u*)(F.xg + (size_t)row * D) + lane;
#pragma unroll
            for (int q = 0; q < 4; ++q) d[64 * q] = (v4u){0u, 0u, 0u, 0u}; }
    }
}
__device__ __forceinline__ void moe_combine_phase(Frame& F) {
    const int gw = F.vcu * NWAVES + F.wave, NGW = F.G * NWAVES, lane = F.lane;
    const bf16* y = F.xg;
    for (int m = gw; m < T; m += NGW) {
        const int s0 = F.tslot[2 * m], s1 = F.tslot[2 * m + 1];
        const float g0 = __builtin_bit_cast(float, F.rec[(size_t)m * 8 + 4]), g1 = __builtin_bit_cast(float, F.rec[(size_t)m * 8 + 5]);
#pragma unroll
        for (int pass = 0; pass < 4; ++pass) {
            const int c0 = (pass * 64 + lane) * 8;
            const v4u a = *(const GAS v4u*)(y + (size_t)s0 * D + c0), bq = *(const GAS v4u*)(y + (size_t)s1 * D + c0);
            float* op = F.out + (size_t)m * D + c0; f32x4 x0 = *(const GAS f32x4*)op, x1 = *(const GAS f32x4*)(op + 4);
            x0.x += g0 * bflo(a.x) + g1 * bflo(bq.x); x0.y += g0 * bfhi(a.x) + g1 * bfhi(bq.x); x0.z += g0 * bflo(a.y) + g1 * bflo(bq.y); x0.w += g0 * bfhi(a.y) + g1 * bfhi(bq.y);
            x1.x += g0 * bflo(a.z) + g1 * bflo(bq.z); x1.y += g0 * bfhi(a.z) + g1 * bfhi(bq.z); x1.z += g0 * bflo(a.w) + g1 * bflo(bq.w); x1.w += g0 * bfhi(a.w) + g1 * bfhi(bq.w);
            *(GAS f32x4*)op = x0; *(GAS f32x4*)(op + 4) = x1;
        }
    }
}

#ifndef MK_PER_PHASE
#define MK_PER_PHASE 0
#endif
struct Args { const float* in[17]; float* out; unsigned char* ws; int ph_lo, ph_hi; };
__global__ void __launch_bounds__(NTHREADS, 2) mk_fwd(Args args) {
    extern __shared__ __attribute__((aligned(16))) unsigned char lds[];
    Frame F;
    F.lds = (LAS unsigned char*)lds;
    F.tid = threadIdx.x; F.lane = F.tid & 63; F.wave = __builtin_amdgcn_readfirstlane(F.tid >> 6);
    F.G = gridDim.x; { const int bx = blockIdx.x; F.vcu = (F.G % 8 == 0) ? (bx % 8) * (F.G / 8) + bx / 8 : bx; }
    unsigned char* ws = args.ws;
    F.ctl = (unsigned*)(ws + WS_CTL);
    F.x = args.in[0]; F.gains = args.in[1]; F.w_in = args.in[2]; F.lbl = args.in[3]; F.onorm = args.in[4]; F.w_ho = args.in[5]; F.w_qkv = args.in[6]; F.qgain = args.in[7]; F.kgain = args.in[8];
    F.w_ao = args.in[9]; F.w_g = args.in[10]; F.w_u = args.in[11]; F.w_d = args.in[12]; F.w_r = args.in[13]; F.mw_g = args.in[14]; F.mw_u = args.in[15]; F.mw_d = args.in[16]; F.out = args.out;
    F.Wt_in = (bf16*)(ws + WS_W_IN); F.Wt_ho = (bf16*)(ws + WS_W_HO); F.Wt_gu = (bf16*)(ws + WS_W_GU); F.Wt_dn = (bf16*)(ws + WS_W_DN); F.Wt_qkv = (bf16*)(ws + WS_W_QKV); F.Wt_ao = (bf16*)(ws + WS_W_AO);
    F.Wt_mgu = (bf16*)(ws + WS_W_MGU); F.Wt_mdn = (bf16*)(ws + WS_W_MDN);
    F.hn = (bf16*)(ws + A_HN); F.big = (bf16*)(ws + A_BIG); F.of = (bf16*)(ws + A_OF); F.ob = (bf16*)(ws + A_OB); F.xg = (bf16*)(ws + A_XG); F.mh = (bf16*)(ws + A_MH);
    F.lse = (float*)(ws + A_LSE); F.rec = (int*)(ws + A_REC); F.tslot = (int*)(ws + A_TSLOT);
    volatile LAS unsigned* MISC = (volatile LAS unsigned*)(F.lds + MISC_OFF);
    if (F.tid < 32) MISC[F.tid] = 0u;
    __syncthreads();
    const int lo = args.ph_lo, hi = args.ph_hi;
    XcdBarrier bar; bar.bar = F.ctl + CW_BAR; bar.x = 0; bar.st = nullptr;
    if (hi - lo > 1) bar = xcd_barrier_post(F.ctl + CW_BAR, MISC + 8);
#define IN(k) (lo <= (k) && (k) < hi)
#define SEAM(k) do { if (IN(k) && IN((k) + 1)) xcd_barrier(bar); } while (0)
    typedef pg8::StaticOrder SO;

    if (IN(0)) { p0_prologue(F); } SEAM(0);
    if (IN(1)) { pg8::Gemm g{F.hn, F.Wt_in, D}; SO S; S.init(T / 256, N_IN / 256, F.G, (int)blockIdx.x); pg8::EpiBf16 E{F.big, N_IN};
        pg8::gemm_phase<pg8::EpiBf16, SO, true, true>(F.lds, g, S, E); } SEAM(1);
    if (IN(2)) { scan_phase(F); } SEAM(2);
    if (IN(3)) { onorm_phase(F); } SEAM(3);
    if (IN(4)) { pg8::Gemm g{F.ob, F.Wt_ho, D}; SO S; S.init(T / 256, D / 256, F.G, (int)blockIdx.x); pg8::EpiResF32 E{F.x, F.out, D};
        pg8::gemm_phase<pg8::EpiResF32, SO, true, true>(F.lds, g, S, E); } SEAM(4);
    if (IN(5)) { rms_phase(F, F.out, F.gains + D, F.hn); } SEAM(5);
    if (IN(6)) { pg8::Gemm g{F.hn, F.Wt_gu, D}; SO S; S.init(T / 256, NGU / 256, F.G, (int)blockIdx.x); pg8::EpiSwiglu E{F.big, FFN};
        pg8::gemm_phase<pg8::EpiSwiglu, SO, true, true>(F.lds, g, S, E); } SEAM(6);
    if (IN(7)) { pg8::Gemm g{F.big, F.Wt_dn, FFN}; SO S; S.init(T / 256, D / 256, F.G, (int)blockIdx.x); pg8::EpiResF32 E{F.out, F.out, D};
        pg8::gemm_phase<pg8::EpiResF32, SO, true, true>(F.lds, g, S, E); } SEAM(7);
    if (IN(8)) { rms_phase(F, F.out, F.gains + 2 * D, F.hn); } SEAM(8);
    if (IN(9)) { pg8::Gemm g{F.hn, F.Wt_qkv, D}; SO S; S.init(T / 256, NQKV / 256, F.G, (int)blockIdx.x); pg8::EpiBf16 E{F.big, NQKV};
        pg8::gemm_phase<pg8::EpiBf16, SO, true, true>(F.lds, g, S, E); } SEAM(9);
    if (IN(10)) { qknorm_rope_phase(F); } SEAM(10);
    if (IN(11)) { attn_phase(F); } SEAM(11);
    if (IN(12)) { attn_combine_phase(F); } SEAM(12);
    if (IN(13)) { pg8::Gemm g{F.ob, F.Wt_ao, D}; SO S; S.init(T / 256, D / 256, F.G, (int)blockIdx.x); pg8::EpiResF32 E{F.out, F.out, D};
        pg8::gemm_phase<pg8::EpiResF32, SO, true, true>(F.lds, g, S, E); } SEAM(13);
    if (IN(14)) { router_phase(F); } SEAM(14);
    if (IN(15)) { gather_phase(F); } SEAM(15);
    if (IN(16)) { int cnt[8], ct[9]; moe_tiles(F, cnt, ct);
        pg8::Gemm g{F.xg, F.Wt_mgu, D}; pg8::MoeOrder S; S.init(ct[8], NMGU / 256, F.G, (int)blockIdx.x);
        S.c1 = ct[1]; S.c2 = ct[2]; S.c3 = ct[3]; S.c4 = ct[4]; S.c5 = ct[5]; S.c6 = ct[6]; S.c7 = ct[7]; S.estride = (size_t)NMGU * D * 2;
        pg8::EpiSwiglu E{F.mh, FE};
        pg8::gemm_phase<pg8::EpiSwiglu, pg8::MoeOrder, true, true>(F.lds, g, S, E); } SEAM(16);
    if (IN(17)) { int cnt[8], ct[9]; moe_tiles(F, cnt, ct);
        pg8::Gemm g{F.mh, F.Wt_mdn, FE}; pg8::MoeOrder S; S.init(ct[8], D / 256, F.G, (int)blockIdx.x);
        S.c1 = ct[1]; S.c2 = ct[2]; S.c3 = ct[3]; S.c4 = ct[4]; S.c5 = ct[5]; S.c6 = ct[6]; S.c7 = ct[7]; S.estride = (size_t)D * FE * 2;
        pg8::EpiBf16 E{F.xg, D};
        pg8::gemm_phase<pg8::EpiBf16, pg8::MoeOrder, true, true>(F.lds, g, S, E); } SEAM(17);
    if (IN(18)) { moe_combine_phase(F); }
#undef IN
#undef SEAM
}

extern "C" void kernel_launch(void* const* d_in, const int* in_sizes, int n_in, void* d_out, int out_size, void* d_ws, size_t ws_size, hipStream_t stream) {
    static int grid = 0;
    if (grid == 0) {
        if (n_in != 17 || out_size != T * D || ws_size < WS_END) { fprintf(stderr, "kernel_launch: unexpected shapes (n_in %d out %d ws %zu need %zu)\n", n_in, out_size, ws_size, (size_t)WS_END); grid = -1; return; }
        int dev = 0, cus = 0, per_cu = 0;
        if (hipGetDevice(&dev) != hipSuccess || hipDeviceGetAttribute(&cus, hipDeviceAttributeMultiprocessorCount, dev) != hipSuccess) { grid = -1; return; }
        if (hipFuncSetAttribute((const void*)mk_fwd, hipFuncAttributeMaxDynamicSharedMemorySize, LDS_BYTES) != hipSuccess) { fprintf(stderr, "kernel_launch: hipFuncSetAttribute failed\n"); grid = -1; return; }
        if (hipOccupancyMaxActiveBlocksPerMultiprocessor(&per_cu, (const void*)mk_fwd, NTHREADS, LDS_BYTES) != hipSuccess || per_cu < 1) { fprintf(stderr, "kernel_launch: occupancy query reports %d\n", per_cu); }
        (void)hipGetLastError();
        grid = cus;
    }
    if (grid < 0) return;
    (void)hipMemsetAsync((char*)d_ws + WS_CTL, 0, CTL_ZERO_BYTES, stream);
    Args a{};
    for (int i = 0; i < 17; ++i) a.in[i] = (const float*)d_in[i];
    a.out = (float*)d_out; a.ws = (unsigned char*)d_ws;
#if MK_PER_PHASE
    for (int p = 0; p < N_PHASES; ++p) { a.ph_lo = p; a.ph_hi = p + 1; hipLaunchKernelGGL(mk_fwd, dim3(grid), dim3(NTHREADS), LDS_BYTES, stream, a); }
#else
    a.ph_lo = 0; a.ph_hi = N_PHASES;
    hipLaunchKernelGGL(mk_fwd, dim3(grid), dim3(NTHREADS), LDS_BYTES, stream, a);
#endif
}
```

```cpp
#include <hip/hip_runtime.h>
#include <cstdio>
#include <cstdint>

namespace pg8 {
#define PG8_LAS __attribute__((address_space(3)))
typedef unsigned short bf16_t;
typedef short bf16x8 __attribute__((ext_vector_type(8)));
typedef float f32x4 __attribute__((ext_vector_type(4)));
typedef unsigned u32x4 __attribute__((ext_vector_type(4)));
constexpr int BM = 256, BK = 64, HALF = 128, HTB = HALF * BK * 2  , STAGE_BYTES = 8 * HTB, NXCD = 8, WGM = 8;

__host__ __device__ __forceinline__ int lds_byte(int r, int c) { const int st = (r >> 4) * 2 + (c >> 5), rr = r & 15, cc = c & 31, ob = rr * 64 + cc * 2; return st * 1024 + (ob ^ (((ob >> 9) & 1) << 5)); }
__host__ __device__ __forceinline__ void stage_rc(int b, int& R, int& C) { const int st = b / 1024, sb = b % 1024, swz = sb ^ (((sb >> 9) & 1) << 5); R = (st >> 1) * 16 + swz / 64; C = (st & 1) * 32 + (swz % 64) / 2; }
__host__ __device__ __forceinline__ int perm32(int rho) { const int n = rho >> 4, i = rho & 15; return 8 * (i >> 2) + 4 * n + (i & 3); }

struct Unit { int pm, pn, ui, ar; };
constexpr int RS_CAP = 30, RS_LDS_OFF = 131072;
struct Gemm { const bf16_t* A; const bf16_t* Bt; int K; };

struct StaticOrder {
    int nM, nN, nwg, G, c;
    __host__ __device__ void init(int nM_, int nN_, int G_, int c_) { nM = nM_; nN = nN_; nwg = nM * nN; G = G_; c = c_; }
    __host__ __device__ bool next(int i, Unit& u) const {
        const long L = (long)i * G + c; if (L >= nwg) return false;
        int wgid = (int)L; { const int q = nwg / NXCD, r = nwg % NXCD, xcd = wgid % NXCD, off = wgid / NXCD; wgid = (xcd < r ? xcd * (q + 1) : r * (q + 1) + (xcd - r) * q) + off; }
        const int nig = WGM * nN, gid = wgid / nig, fm = gid * WGM, gsz = (nM - fm) < WGM ? (nM - fm) : WGM;
        u.pm = fm + ((wgid % nig) % gsz); u.pn = (wgid % nig) / gsz; return true;
    }
    __device__ __forceinline__ const char* a_ptr(const Gemm& g, const Unit& u, size_t tstep) const { return (const char*)g.A + (size_t)u.pm * tstep; }
    __device__ __forceinline__ int arow0(const Unit& u) const { return u.pm * BM; }
    __device__ __forceinline__ const char* b_ptr(const Gemm& g, const Unit& u, size_t tstep) const { return (const char*)g.Bt + (size_t)u.pn * tstep; }
    __device__ __forceinline__ void a_ready(const Unit&) const {}
    __device__ __forceinline__ void done(const Unit&) const {}
};
struct MoeOrder : StaticOrder {
    int c1, c2, c3, c4, c5, c6, c7; size_t estride; int avirt;
    __device__ __forceinline__ int tile0(int pm) const { int t = 0; t = pm >= c1 ? c1 : t; t = pm >= c2 ? c2 : t; t = pm >= c3 ? c3 : t; t = pm >= c4 ? c4 : t; t = pm >= c5 ? c5 : t; t = pm >= c6 ? c6 : t; t = pm >= c7 ? c7 : t; return t; }
    __device__ __forceinline__ int arow0(const Unit& u) const { return avirt ? __builtin_amdgcn_readfirstlane(expert(u.pm) * avirt + (u.pm - tile0(u.pm)) * BM) : u.pm * BM; }
    __device__ __forceinline__ const char* a_ptr(const Gemm& g, const Unit& u, size_t tstep) const { return (const char*)g.A + (size_t)arow0(u) * (tstep / BM); }
    __device__ __forceinline__ int expert(int pm) const { return (pm >= c1) + (pm >= c2) + (pm >= c3) + (pm >= c4) + (pm >= c5) + (pm >= c6) + (pm >= c7); }
    __device__ __forceinline__ const char* b_ptr(const Gemm& g, const Unit& u, size_t tstep) const { return (const char*)g.Bt + (size_t)__builtin_amdgcn_readfirstlane(expert(u.pm)) * estride + (size_t)u.pn * tstep; }
};
struct MoeTailOrder : MoeOrder {
    int pm0, ntu;
    __device__ __forceinline__ bool next(int i, Unit& u) const { const long L = (long)i * G + c; if (L >= ntu) return false; u.pm = pm0 + (int)L / nN; u.pn = (int)L % nN; return true; }
};

__device__ __forceinline__ unsigned cvt_pk_bf16(float lo, float hi) { unsigned r; asm volatile("v_cvt_pk_bf16_f32 %0, %1, %2" : "=v"(r) : "v"(lo), "v"(hi)); return r; }
__device__ __forceinline__ float silu_f(float x) { return x * __builtin_amdgcn_rcpf(1.0f + __expf(-x)); }
typedef int v8i __attribute__((ext_vector_type(8))); typedef int v4i __attribute__((ext_vector_type(4)));
__device__ __forceinline__ v8i cat8(bf16x8 a, bf16x8 b) { return __builtin_shufflevector(__builtin_bit_cast(v4i, a), __builtin_bit_cast(v4i, b), 0, 1, 2, 3, 4, 5, 6, 7); }
#ifndef PK8_BIAS
#define PK8_BIAS 128.0f
#endif
__device__ __forceinline__ unsigned pk4_i8(float a, float b, float c, float d) {
    unsigned r = __builtin_amdgcn_cvt_pk_u8_f32(a + PK8_BIAS, 0u, 0u);
    r = __builtin_amdgcn_cvt_pk_u8_f32(b + PK8_BIAS, 1u, r); r = __builtin_amdgcn_cvt_pk_u8_f32(c + PK8_BIAS, 2u, r); r = __builtin_amdgcn_cvt_pk_u8_f32(d + PK8_BIAS, 3u, r);
    return r ^ 0x80808080u; }
__device__ __forceinline__ float clamp448(float x) { return fminf(fmaxf(x, -448.f), 448.f); }
__device__ __forceinline__ unsigned pk4_fp8(float a, float b, float c, float d) { int w = 0; w = __builtin_amdgcn_cvt_pk_fp8_f32(clamp448(a), clamp448(b), w, false); w = __builtin_amdgcn_cvt_pk_fp8_f32(clamp448(c), clamp448(d), w, true); return (unsigned)w; }

__device__ __forceinline__ float row_scale(const float* rowscale, const Unit& u, int rloc  , PG8_LAS unsigned char* lds) {
    if (u.ui < RS_CAP) return __builtin_bit_cast(float, (unsigned)(*(const PG8_LAS unsigned short*)(lds + RS_LDS_OFF + (u.ui * 256 + rloc) * 2)) << 16);
    float x; const __attribute__((address_space(1))) float* p = (const __attribute__((address_space(1))) float*)rowscale + (u.ar + rloc);
    asm volatile("global_load_dword %0, %1, off\n\ts_waitcnt vmcnt(0)" : "=&v"(x) : "v"(p) : "memory");
    return x;
}
struct EpiBf16 {
    static constexpr bool PERM = true, AFTER_DRAIN = false;
    bf16_t* O; int ldc; float sc; const float* rowscale; int hgrn_act;
    __device__ __forceinline__ void operator()(const f32x4 (&acc)[2][2][4][2], const Unit& u, int wr, int wc, int fr, int fq, PG8_LAS unsigned char* lds) const {
        const int row0 = u.pm * BM + wr * 64 + fr, col0 = u.pn * BM + wc * 32 + 8 * fq;
#pragma unroll
        for (int ai = 0; ai < 2; ++ai)
#pragma unroll
            for (int m = 0; m < 4; ++m) { bf16_t* rowp = O + (size_t)(row0 + ai * HALF + m * 16) * ldc + col0;
                const float s = rowscale ? sc * row_scale(rowscale, u, wr * 64 + fr + ai * HALF + m * 16, lds) : sc;
#pragma unroll
                for (int bj = 0; bj < 2; ++bj) { f32x4 v0 = acc[ai][bj][m][0] * s, v1 = acc[ai][bj][m][1] * s;
                    if (hgrn_act) { const int sec = (u.pn * BM) >> 11;
                        if (sec <= 2) {
#pragma unroll
                            for (int j = 0; j < 4; ++j) { const float s0 = __builtin_amdgcn_rcpf(1.0f + __expf(-v0[j])), s1 = __builtin_amdgcn_rcpf(1.0f + __expf(-v1[j])); v0[j] = sec == 0 ? v0[j] * s0 : s0; v1[j] = sec == 0 ? v1[j] * s1 : s1; } } }
                    u32x4 w; w.x = cvt_pk_bf16(v0[0], v0[1]); w.y = cvt_pk_bf16(v0[2], v0[3]); w.z = cvt_pk_bf16(v1[0], v1[1]); w.w = cvt_pk_bf16(v1[2], v1[3]);
                    *(u32x4*)(rowp + bj * HALF) = w; } }
    }
};
struct EpiSwiglu {
    static constexpr bool PERM = true, AFTER_DRAIN = false;
    bf16_t* O; int ldc; float si; const float* rowscale;
    __device__ __forceinline__ void operator()(const f32x4 (&acc)[2][2][4][2], const Unit& u, int wr, int wc, int fr, int fq, PG8_LAS unsigned char* lds) const {
        const int row0 = u.pm * BM + wr * 64 + fr, col0 = u.pn * HALF + wc * 32 + 8 * fq;
#pragma unroll
        for (int ai = 0; ai < 2; ++ai)
#pragma unroll
            for (int m = 0; m < 4; ++m) { bf16_t* rowp = O + (size_t)(row0 + ai * HALF + m * 16) * ldc + col0;
                const float s = rowscale ? si * row_scale(rowscale, u, wr * 64 + fr + ai * HALF + m * 16, lds) : si;
                const f32x4 g0 = acc[ai][0][m][0] * s, g1 = acc[ai][0][m][1] * s, u0 = acc[ai][1][m][0] * s, u1 = acc[ai][1][m][1] * s;
                float h[8];
#pragma unroll
                for (int j = 0; j < 4; ++j) { h[j] = silu_f(g0[j]) * u0[j]; h[4 + j] = silu_f(g1[j]) * u1[j]; }
                u32x4 w; w.x = cvt_pk_bf16(h[0], h[1]); w.y = cvt_pk_bf16(h[2], h[3]); w.z = cvt_pk_bf16(h[4], h[5]); w.w = cvt_pk_bf16(h[6], h[7]);
                *(u32x4*)rowp = w; }
    }
};
struct EpiSwigluF8 {
    static constexpr bool PERM = true, AFTER_DRAIN = false;
    unsigned char* O; int ldc; float si, so;
    __device__ __forceinline__ void operator()(const f32x4 (&acc)[2][2][4][2], const Unit& u, int wr, int wc, int fr, int fq, PG8_LAS unsigned char* lds) const {
        const int row0 = u.pm * BM + wr * 64 + fr, col0 = u.pn * HALF + wc * 32 + 8 * fq;
#pragma unroll
        for (int ai = 0; ai < 2; ++ai)
#pragma unroll
            for (int m = 0; m < 4; ++m) { unsigned char* rowp = O + (size_t)(row0 + ai * HALF + m * 16) * ldc + col0;
                const f32x4 g0 = acc[ai][0][m][0] * si, g1 = acc[ai][0][m][1] * si, u0 = acc[ai][1][m][0] * (si * so), u1 = acc[ai][1][m][1] * (si * so);
                float h[8];
#pragma unroll
                for (int j = 0; j < 4; ++j) { h[j] = silu_f(g0[j]) * u0[j]; h[4 + j] = silu_f(g1[j]) * u1[j]; }
                typedef unsigned u32x2 __attribute__((ext_vector_type(2)));
                u32x2 w; w.x = pk4_fp8(h[0], h[1], h[2], h[3]); w.y = pk4_fp8(h[4], h[5], h[6], h[7]);
                *(u32x2*)rowp = w; }
    }
};
struct EpiSwigluQ8 {
    static constexpr bool PERM = true, AFTER_DRAIN = false;
    unsigned char* O; int ldc; float si, so; const float* rowscale;
    __device__ __forceinline__ void operator()(const f32x4 (&acc)[2][2][4][2], const Unit& u, int wr, int wc, int fr, int fq, PG8_LAS unsigned char* lds) const {
        const int row0 = u.pm * BM + wr * 64 + fr, col0 = u.pn * HALF + wc * 32 + 8 * fq;
#pragma unroll
        for (int ai = 0; ai < 2; ++ai)
#pragma unroll
            for (int m = 0; m < 4; ++m) { const int row = row0 + ai * HALF + m * 16; unsigned char* rowp = O + (size_t)row * ldc + col0;
                const float s = si * row_scale(rowscale, u, wr * 64 + fr + ai * HALF + m * 16, lds);
                const f32x4 g0 = acc[ai][0][m][0] * s, g1 = acc[ai][0][m][1] * s, u0 = acc[ai][1][m][0] * (s * so), u1 = acc[ai][1][m][1] * (s * so);
                float h[8];
#pragma unroll
                for (int j = 0; j < 4; ++j) { h[j] = silu_f(g0[j]) * u0[j]; h[4 + j] = silu_f(g1[j]) * u1[j]; }
                typedef unsigned u32x2 __attribute__((ext_vector_type(2)));
                u32x2 w; w.x = pk4_i8(h[0], h[1], h[2], h[3]); w.y = pk4_i8(h[4], h[5], h[6], h[7]);
                *(u32x2*)rowp = w; }
    }
};
struct EpiResF32 {
    static constexpr bool PERM = false, AFTER_DRAIN = false;
    const float* base; float* out; int ldc; float sc; const float* rowscale;
    __device__ __forceinline__ void operator()(const f32x4 (&acc)[2][2][4][2], const Unit& u, int wr, int wc, int fr, int fq, PG8_LAS unsigned char* lds) const {
        const int row0 = u.pm * BM + wr * 64 + fr, col0 = u.pn * BM + wc * 32 + 4 * fq;
#pragma unroll
        for (int ai = 0; ai < 2; ++ai)
#pragma unroll
            for (int m = 0; m < 4; ++m) { const size_t off = (size_t)(row0 + ai * HALF + m * 16) * ldc + col0;
                const float s = rowscale ? sc * row_scale(rowscale, u, wr * 64 + fr + ai * HALF + m * 16, lds) : sc;
#pragma unroll
                for (int bj = 0; bj < 2; ++bj)
#pragma unroll
                    for (int n = 0; n < 2; ++n) { const f32x4 bs = *(const f32x4*)(base + off + bj * HALF + n * 16); *(f32x4*)(out + off + bj * HALF + n * 16) = bs + acc[ai][bj][m][n] * s; }
                asm volatile("" ::: "memory"); }
    }
};

template <class Epi, class Sched, bool ALIGN_EPI = false, bool SP2 = false, int QM = 0>
__device__ __forceinline__ void gemm_phase(PG8_LAS unsigned char* lds, const Gemm g, const Sched& S, const Epi& E, const int tid) {
    constexpr bool F8 = (QM == 1), I8 = (QM == 2);
    const int wid = __builtin_amdgcn_readfirstlane(tid >> 6), lane = tid & 63, wr = wid >> 2, wc = wid & 3, fr = lane & 15, fq = lane >> 4;
    const int K = g.K, nt = K / BK;
    unsigned voffA[2], voffB[2];
#pragma unroll
    for (int i = 0; i < 2; ++i) { int R, C; stage_rc(tid * 16 + i * 8192, R, C); const int Rb = Epi::PERM ? ((R & ~31) + perm32(R & 31)) : R;
        voffA[i] = (unsigned)(R * K + C) * 2u; voffB[i] = (unsigned)(Rb * K + C) * 2u; }
    const size_t kstep = (size_t)(BK * 2);
    const size_t hstep = (size_t)HALF * K * 2;
    const size_t tstep = 2 * hstep;
    const unsigned ldsw = (unsigned)wid * 1024u;
    const int aoff = F8 ? lds_byte(wr * 64 + fr, (fq & 1) * 16) + (fq >> 1) * 1024 : lds_byte(wr * 64 + fr, fq * 8), boff = F8 ? lds_byte(wc * 32 + fr, (fq & 1) * 16) + (fq >> 1) * 1024 : lds_byte(wc * 32 + fr, fq * 8);
#define PG8_SA(b, h) (((b) * 2 + (h)) * HTB)
#define PG8_SB(b, h) ((4 + (b) * 2 + (h)) * HTB)
#define PG8_STAGE(bufoff, gbase, voff) do { _Pragma("unroll") for (int _i = 0; _i < 2; ++_i) \
        __builtin_amdgcn_global_load_lds((const __attribute__((address_space(1))) unsigned*)((const __attribute__((address_space(1))) char*)(gbase) + (voff)[_i]), (PG8_LAS unsigned*)(lds + (bufoff) + ldsw + _i * 8192), 16, 0, 0); } while (0)
#define PG8_LDA(dst, b, h) do { _Pragma("unroll") for (int m = 0; m < 4; ++m) { if constexpr (F8) dst##8[m] = cat8(*(const PG8_LAS bf16x8*)(lds + PG8_SA(b, h) + aoff + m * 2048), *(const PG8_LAS bf16x8*)(lds + PG8_SA(b, h) + aoff + m * 2048 + 16)); \
        else { _Pragma("unroll") for (int k = 0; k < 2; ++k) dst[m][k] = *(const PG8_LAS bf16x8*)(lds + PG8_SA(b, h) + aoff + m * 2048 + k * 1024); } } } while (0)
#define PG8_LDB(dst, b, h) do { _Pragma("unroll") for (int n = 0; n < 2; ++n) { if constexpr (F8) dst##8[n] = cat8(*(const PG8_LAS bf16x8*)(lds + PG8_SB(b, h) + boff + n * 2048), *(const PG8_LAS bf16x8*)(lds + PG8_SB(b, h) + boff + n * 2048 + 16)); \
        else { _Pragma("unroll") for (int k = 0; k < 2; ++k) dst[n][k] = *(const PG8_LAS bf16x8*)(lds + PG8_SB(b, h) + boff + n * 2048 + k * 1024); } } } while (0)
#define PG8_MMA(ai, bj, At, Bt) do { __builtin_amdgcn_s_setprio(1); _Pragma("unroll") for (int m = 0; m < 4; ++m) _Pragma("unroll") for (int n = 0; n < 2; ++n) { \
        if constexpr (F8) acc[ai][bj][m][n] = __builtin_amdgcn_mfma_scale_f32_16x16x128_f8f6f4(Bt##8[n], At##8[m], acc[ai][bj][m][n], 0, 0, 0, 0x7f7f7f7f, 0, 0x7f7f7f7f); \
        else if constexpr (I8) { _Pragma("unroll") for (int k = 0; k < 2; ++k) acc[ai][bj][m][n] = __builtin_bit_cast(f32x4, __builtin_amdgcn_mfma_i32_16x16x64_i8(__builtin_bit_cast(v4i, Bt[n][k]), __builtin_bit_cast(v4i, At[m][k]), __builtin_bit_cast(v4i, acc[ai][bj][m][n]), 0, 0, 0)); } \
        else { _Pragma("unroll") for (int k = 0; k < 2; ++k) acc[ai][bj][m][n] = __builtin_amdgcn_mfma_f32_16x16x32_bf16(Bt[n][k], At[m][k], acc[ai][bj][m][n], 0, 0, 0); } } __builtin_amdgcn_s_setprio(0); } while (0)
#define PG8_WAIT_V(n) asm volatile("s_waitcnt vmcnt(" #n ")" ::: "memory")
#define PG8_WAIT_L(n) asm volatile("s_waitcnt lgkmcnt(" #n ")" ::: "memory")
#define PG8_BAR __builtin_amdgcn_s_barrier()
#define PG8_SCHED __builtin_amdgcn_sched_barrier(0)
    Unit cur, nxt; int ui = 0;
    if (!S.next(0, cur)) return;
    cur.ui = 0; cur.ar = S.arow0(cur);
    if (E.rowscale) {
        Unit tu;
        for (int i = tid >> 8; i < RS_CAP && S.next(i, tu); i += 2)
            *(PG8_LAS unsigned short*)(lds + RS_LDS_OFF + (i * 256 + (tid & 255)) * 2) = (unsigned short)(__builtin_bit_cast(unsigned, E.rowscale[S.arow0(tu) + (tid & 255)]) >> 16);
        asm volatile("s_waitcnt vmcnt(0) lgkmcnt(0)" ::: "memory"); __builtin_amdgcn_s_barrier(); asm volatile("" ::: "memory");
    }
    f32x4 acc[2][2][4][2];
#pragma unroll
    for (int a = 0; a < 2; ++a)
#pragma unroll
        for (int b = 0; b < 2; ++b)
#pragma unroll
            for (int m = 0; m < 4; ++m)
#pragma unroll
                for (int n = 0; n < 2; ++n) acc[a][b][m][n] = (f32x4){0.f, 0.f, 0.f, 0.f};
    bf16x8 At[4][2], B0[2][2], B1[2][2]; v8i At8[4], B08[2], B18[2];
    const char* cA = S.a_ptr(g, cur, tstep); const char* cB = S.b_ptr(g, cur, tstep);
    S.a_ready(cur);
    if constexpr (SP2) {
        PG8_STAGE(PG8_SB(0, 0), cB, voffB); PG8_STAGE(PG8_SB(0, 1), cB + hstep, voffB); PG8_STAGE(PG8_SA(0, 0), cA, voffA); PG8_STAGE(PG8_SA(0, 1), cA + hstep, voffA);
        if (wr == 1) PG8_BAR;
        PG8_WAIT_V(2); PG8_BAR;
        PG8_STAGE(PG8_SB(1, 0), cB + kstep, voffB); PG8_STAGE(PG8_SA(1, 0), cA + kstep, voffA); PG8_STAGE(PG8_SB(1, 1), cB + hstep + kstep, voffB);
        PG8_WAIT_V(6); PG8_BAR;
    } else {
        PG8_STAGE(PG8_SB(0, 0), cB, voffB); PG8_STAGE(PG8_SA(0, 0), cA, voffA); PG8_STAGE(PG8_SB(0, 1), cB + hstep, voffB); PG8_STAGE(PG8_SA(0, 1), cA + hstep, voffA);
        if (wr == 1) PG8_BAR;
        PG8_WAIT_V(4); PG8_BAR;
        PG8_STAGE(PG8_SB(1, 0), cB + kstep, voffB); PG8_STAGE(PG8_SA(1, 0), cA + kstep, voffA); PG8_STAGE(PG8_SB(1, 1), cB + hstep + kstep, voffB);
        PG8_WAIT_V(6); PG8_BAR;
    }
    for (;;) {
        const bool has_next = S.next(ui + 1, nxt);
        const char* nA = has_next ? S.a_ptr(g, nxt, tstep) : cA; const char* nB = has_next ? S.b_ptr(g, nxt, tstep) : cB;
        for (int t = 0; t < nt; t += 2) {
            const bool last = (t == nt - 2);
            const char* a1 = cA + (size_t)(t + 1) * kstep;
            const char* a2 = last ? nA : cA + (size_t)(t + 2) * kstep; const char* b2 = last ? nB : cB + (size_t)(t + 2) * kstep;
            const char* a3 = a2 + kstep; const char* b3 = b2 + kstep;
            const char* a1h = a1 + hstep; const char* a2h = a2 + hstep; const char* b2h = b2 + hstep; const char* b3h = b3 + hstep;
            asm volatile("" : "+v"(voffA[0]), "+v"(voffA[1]), "+v"(voffB[0]), "+v"(voffB[1]));
            asm volatile("" : "+s"(a1h), "+s"(a2), "+s"(a2h), "+s"(a3), "+s"(b2), "+s"(b2h), "+s"(b3), "+s"(b3h));
            if (last && has_next) S.a_ready(nxt);
            if constexpr (SP2) {
            PG8_LDB(B0, 0, 0); PG8_LDB(B1, 0, 1); PG8_SCHED; PG8_LDA(At, 0, 0); PG8_STAGE(PG8_SA(1, 1), a1h, voffA);
            PG8_WAIT_V(8); PG8_WAIT_L(0); PG8_BAR; PG8_MMA(0, 0, At, B0); PG8_MMA(0, 1, At, B1); PG8_BAR; PG8_SCHED;
            PG8_LDA(At, 0, 1); PG8_STAGE(PG8_SB(0, 0), b2, voffB); PG8_STAGE(PG8_SB(0, 1), b2h, voffB); PG8_STAGE(PG8_SA(0, 0), a2, voffA);
            PG8_WAIT_V(8); PG8_WAIT_L(0); PG8_BAR; PG8_MMA(1, 0, At, B0); PG8_MMA(1, 1, At, B1); PG8_BAR; PG8_SCHED;
            PG8_LDB(B0, 1, 0); PG8_LDB(B1, 1, 1); PG8_SCHED; PG8_LDA(At, 1, 0); PG8_STAGE(PG8_SA(0, 1), a2h, voffA);
            PG8_WAIT_V(8); PG8_WAIT_L(0); PG8_BAR; PG8_MMA(0, 0, At, B0); PG8_MMA(0, 1, At, B1); PG8_BAR; PG8_SCHED;
            PG8_LDA(At, 1, 1); PG8_STAGE(PG8_SB(1, 0), b3, voffB); PG8_STAGE(PG8_SB(1, 1), b3h, voffB); PG8_STAGE(PG8_SA(1, 0), a3, voffA);
            PG8_WAIT_V(8); PG8_WAIT_L(0); PG8_BAR; PG8_MMA(1, 0, At, B0); PG8_MMA(1, 1, At, B1); PG8_BAR; PG8_SCHED;
            } else {
            PG8_LDB(B0, 0, 0); PG8_SCHED; PG8_LDA(At, 0, 0); PG8_STAGE(PG8_SA(1, 1), a1h, voffA);
            PG8_WAIT_L(8); PG8_BAR; PG8_WAIT_L(0); PG8_MMA(0, 0, At, B0); PG8_BAR; PG8_SCHED;
            PG8_LDB(B1, 0, 1); PG8_STAGE(PG8_SB(0, 0), b2, voffB);
            PG8_BAR; PG8_WAIT_L(0); PG8_MMA(0, 1, At, B1); PG8_BAR;
            PG8_LDA(At, 0, 1); PG8_STAGE(PG8_SA(0, 0), a2, voffA);
            PG8_BAR; PG8_WAIT_L(0); PG8_MMA(1, 0, At, B0); PG8_BAR; PG8_SCHED;
            PG8_STAGE(PG8_SB(0, 1), b2h, voffB);
            PG8_WAIT_V(6); PG8_BAR; PG8_MMA(1, 1, At, B1); PG8_BAR;
            PG8_LDB(B0, 1, 0); PG8_SCHED; PG8_LDA(At, 1, 0); PG8_STAGE(PG8_SA(0, 1), a2h, voffA);
            PG8_WAIT_L(8); PG8_BAR; PG8_WAIT_L(0); PG8_MMA(0, 0, At, B0); PG8_BAR; PG8_SCHED;
            PG8_LDB(B1, 1, 1); PG8_STAGE(PG8_SB(1, 0), b3, voffB);
            PG8_BAR; PG8_WAIT_L(0); PG8_MMA(0, 1, At, B1); PG8_BAR;
            PG8_LDA(At, 1, 1); PG8_STAGE(PG8_SA(1, 0), a3, voffA);
            PG8_BAR; PG8_WAIT_L(0); PG8_MMA(1, 0, At, B0); PG8_BAR; PG8_SCHED;
            PG8_STAGE(PG8_SB(1, 1), b3h, voffB);
            PG8_WAIT_V(6); PG8_BAR; PG8_MMA(1, 1, At, B1); PG8_BAR;
            }
        }
        if constexpr (ALIGN_EPI) { if (wr == 0) PG8_BAR; }
        if constexpr (I8) {
#pragma unroll
            for (int a = 0; a < 2; ++a)
#pragma unroll
                for (int b = 0; b < 2; ++b)
#pragma unroll
                    for (int m = 0; m < 4; ++m)
#pragma unroll
                        for (int n = 0; n < 2; ++n) { const v4i iv = __builtin_bit_cast(v4i, acc[a][b][m][n]); acc[a][b][m][n] = (f32x4){(float)iv[0], (float)iv[1], (float)iv[2], (float)iv[3]}; } }
        if constexpr (!Epi::AFTER_DRAIN) { E(acc, cur, wr, wc, fr, fq, lds); S.done(cur); }
        if (!has_next) break;
#pragma unroll
        for (int a = 0; a < 2; ++a)
#pragma unroll
            for (int b = 0; b < 2; ++b)
#pragma unroll
                for (int m = 0; m < 4; ++m)
#pragma unroll
                    for (int n = 0; n < 2; ++n) acc[a][b][m][n] = (f32x4){0.f, 0.f, 0.f, 0.f};
        cur = nxt; cA = nA; cB = nB; ++ui; cur.ui = ui; cur.ar = S.arow0(cur);
        if constexpr (ALIGN_EPI) { if (wr == 1) PG8_BAR; }
    }
    PG8_WAIT_V(0);
    if constexpr (!ALIGN_EPI) { if (wr == 0) PG8_BAR; }
    PG8_BAR;
    if constexpr (Epi::AFTER_DRAIN) { E.fused(acc, cur, wr, wc, fr, fq, lds, wid, lane); S.done(cur); }
#undef PG8_SA
#undef PG8_SB
#undef PG8_STAGE
#undef PG8_LDA
#undef PG8_LDB
#undef PG8_MMA
#undef PG8_WAIT_V
#undef PG8_WAIT_L
#undef PG8_BAR
#undef PG8_SCHED
}
}

constexpr int T = 16384, D = 2048, SEQ = 4096, NBATCH = 4, NH = 16, HD = 128;
constexpr int N_IN = 10240, FFN = 5504, NGU = 2 * FFN, NQKV = 3 * D, NE = 8, FE = 7168, NMGU = 2 * FE;
constexpr int FFNP = 5632;
constexpr int P_MAX = 2 * T + NE * 256;
constexpr float EPS = 1e-6f;
constexpr int NWAVES = 8, NTHREADS = 512;

constexpr size_t MiB = 1u << 20;
constexpr size_t WS_CTL = 0, CTL_ZERO_BYTES = 1 * MiB;
constexpr size_t WS_W_IN  = 1 * MiB;
constexpr size_t WS_W_HO  = WS_W_IN  + (size_t)N_IN * D * 2;
constexpr size_t WS_W_GU  = WS_W_HO  + (size_t)D * D * 2;
constexpr size_t WS_W_DN  = WS_W_GU  + (size_t)NGU * D * 2;
constexpr size_t WS_W_QKV = WS_W_DN  + (size_t)D * FFN * 2;
constexpr size_t WS_W_AO  = WS_W_QKV + (size_t)NQKV * D * 2;
constexpr size_t WS_W_MGU = WS_W_AO  + (size_t)D * D * 2;
constexpr size_t WS_W_MDN = WS_W_MGU + (size_t)NE * NMGU * D;
constexpr size_t WS_ARENA = WS_W_MDN + (size_t)NE * D * FE;
constexpr size_t A_HN   = WS_ARENA;
constexpr size_t A_BIG  = A_HN + (size_t)T * D * 2;
constexpr size_t A_OF   = A_BIG + (size_t)T * N_IN * 2;
constexpr size_t A_LSE  = A_OF + (size_t)3 * T * D * 2;
constexpr size_t A_OB   = A_LSE + (size_t)3 * T * NH * 4;
constexpr size_t A_XG   = A_BIG;
constexpr size_t A_MH   = A_XG + (size_t)NE * T * D;
static_assert((size_t)NE * T * D >= (size_t)P_MAX * D * 2, "y fits in the xg region");
constexpr size_t A_MH_OLD_UNUSED = 0;
constexpr size_t A_REC  = (A_MH + (size_t)P_MAX * FE > A_OB + (size_t)T * D * 2) ? A_MH + (size_t)P_MAX * FE : A_OB + (size_t)T * D * 2;
constexpr float Q_W2048 = 127.f / (4.f * 0.022097087f), Q_W7168 = 127.f / (4.f * 0.011811350f), Q_HID = 127.f / 8.f, Q_W5504 = 127.f / (4.f * 0.013479011f);

constexpr size_t A_TSLOT = A_REC + (size_t)T * 32;
constexpr size_t WS_END = A_TSLOT + (size_t)T * 8;
constexpr size_t A_RSTOK = A_TSLOT + (size_t)T * 8;
constexpr size_t A_RSSLOT = A_RSTOK + (size_t)T * 4;
constexpr size_t WS_END2 = A_RSSLOT + (size_t)NE * T * 4;
static_assert(WS_END2 < (size_t)1750 * MiB, "workspace map too large");
static_assert(WS_END < (size_t)1750 * MiB, "workspace map too large");
constexpr int CW_BAR = 4096;
constexpr int CW_MOE = 2048;
constexpr int N_PHASES = 19;

constexpr int RING_BYTES = 131072;
constexpr int LDS_BYTES = 147456;
constexpr int MISC_OFF = LDS_BYTES - 128;

#define GAS __attribute__((address_space(1)))
#define LAS __attribute__((address_space(3)))
typedef unsigned short bf16;
typedef unsigned v4u __attribute__((ext_vector_type(4)));
typedef unsigned v2u __attribute__((ext_vector_type(2)));
typedef float f32x4 __attribute__((ext_vector_type(4)));
typedef float f32x2 __attribute__((ext_vector_type(2)));
typedef short bf16x8 __attribute__((ext_vector_type(8)));
#define RLX_AGENT __ATOMIC_RELAXED, __HIP_MEMORY_SCOPE_AGENT
#define LDS_WAIT() asm volatile("s_waitcnt lgkmcnt(0)" ::: "memory")
__device__ __forceinline__ unsigned f2bf(float f) { unsigned u = __builtin_bit_cast(unsigned, f); return (u + 0x7fffu + ((u >> 16) & 1u)) >> 16; }
typedef float f32x2c __attribute__((ext_vector_type(2))); typedef __bf16 bf16x2c __attribute__((ext_vector_type(2)));
__device__ __forceinline__ unsigned pk2(float lo, float hi) { f32x2c v; v.x = lo; v.y = hi; return __builtin_bit_cast(unsigned, __builtin_convertvector(v, bf16x2c)); }
__device__ __forceinline__ float bflo(unsigned w) { return __builtin_bit_cast(float, w << 16); }
__device__ __forceinline__ float bfhi(unsigned w) { return __builtin_bit_cast(float, w & 0xffff0000u); }
__device__ __forceinline__ float bf2f(bf16 h) { return __builtin_bit_cast(float, (unsigned)h << 16); }

#define XB_TMO      128
#define XB_XCNT(j)  (256  + 64 * (j))
#define XB_XSUB(j)  (1280 + 64 * (j))
#define XB_XGEN(j)  (2304 + 64 * (j))
#define XB_TOP      3328
#define XB_TOPGEN   3392
#define XCD_BAR_WORDS 3456
#define XB_SPIN_CAP (1u << 18)
__device__ __forceinline__ unsigned xb_ld(unsigned* p)              { return __hip_atomic_load(p, __ATOMIC_RELAXED, __HIP_MEMORY_SCOPE_AGENT); }
__device__ __forceinline__ unsigned xb_add(unsigned* p, unsigned v) { return __hip_atomic_fetch_add(p, v, __ATOMIC_RELAXED, __HIP_MEMORY_SCOPE_AGENT); }
__device__ __forceinline__ unsigned xb_xcc_id() { return (unsigned)__builtin_amdgcn_s_getreg((3 << 11) | 20) & 0xFu; }
#define XB_SPIN(cond, bar) do { unsigned _sp = 0; while (cond) { __builtin_amdgcn_s_sleep(1); \
    if ((++_sp & 255u) == 0u) { if (xb_ld(&(bar)[XB_TMO])) break; if (_sp > XB_SPIN_CAP) { atomicAdd(&(bar)[XB_TMO], 1u); break; } } } } while (0)
struct XcdBarrier { unsigned* bar; unsigned x; volatile LAS unsigned* st; };
__device__ __forceinline__ XcdBarrier xcd_barrier_post(unsigned* bar, volatile LAS unsigned* st) {
    XcdBarrier b; b.bar = bar; b.x = xb_xcc_id(); b.st = st;
    if (threadIdx.x == 0) (void)xb_add(&bar[XB_XCNT(b.x)], 1u);
    return b;
}
__device__ __forceinline__ void xcd_barrier_complete(unsigned* bar, unsigned x, unsigned& nloc, unsigned& nx) {
    const unsigned G = gridDim.x * gridDim.y * gridDim.z;
    unsigned sum, cnt, mine, sp = 0u;
    for (;;) {
        sum = 0u; cnt = 0u; mine = 0u;
#pragma unroll
        for (unsigned j = 0; j < 16; ++j) { const unsigned c = xb_ld(&bar[XB_XCNT(j)]); sum += c; cnt += (c > 0u) ? 1u : 0u; mine = (j == x) ? c : mine; }
        if (sum == G) break;
        __builtin_amdgcn_s_sleep(1);
        if ((++sp & 255u) == 0u) { if (xb_ld(&bar[XB_TMO])) break; if (sp > XB_SPIN_CAP) { atomicAdd(&bar[XB_TMO], 1u); break; } }
    }
    nloc = mine > 0u ? mine : 1u; nx = cnt > 0u ? cnt : 1u;
}
__device__ __forceinline__ void xcd_barrier(const XcdBarrier& b, const bool leader  ) {
    asm volatile("s_waitcnt vmcnt(0)" ::: "memory");
    __syncthreads();
    if (leader) {
        unsigned* bar = b.bar;
        __builtin_amdgcn_s_waitcnt(0);
        unsigned nloc = b.st[0], nx = b.st[1];
        if (nloc == 0u) { xcd_barrier_complete(bar, b.x, nloc, nx); b.st[0] = nloc; b.st[1] = nx; }
        const unsigned old = xb_add(&bar[XB_XSUB(b.x)], 1u);
        const unsigned gen = old / nloc;
        if (old + 1u == (gen + 1u) * nloc) {
            __builtin_amdgcn_fence(__ATOMIC_RELEASE, "agent");
            asm volatile("s_waitcnt vmcnt(0)" ::: "memory");
            const unsigned og = xb_add(&bar[XB_TOP], 1u);
            const unsigned tg = og / nx;
            if (og + 1u == (tg + 1u) * nx) xb_add(&bar[XB_TOPGEN], 1u);
            else XB_SPIN(xb_ld(&bar[XB_TOPGEN]) == tg, bar);
            __builtin_amdgcn_fence(__ATOMIC_ACQUIRE, "agent");
            xb_add(&bar[XB_XGEN(b.x)], 1u);
            asm volatile("s_waitcnt vmcnt(0)" ::: "memory");
        } else {
            XB_SPIN(xb_ld(&bar[XB_XGEN(b.x)]) == gen, bar);
            __builtin_amdgcn_fence(__ATOMIC_ACQUIRE, "agent");
            asm volatile("s_waitcnt vmcnt(0)" ::: "memory");
        }
    }
    __syncthreads();
}

struct Args { const float* in[17]; float* out; unsigned char* ws; int ph_lo, ph_hi; };
#define KARG ((const __attribute__((address_space(4))) Args*)__builtin_amdgcn_kernarg_segment_ptr())
struct Frame {
    LAS unsigned char* lds;
    unsigned* ctl;
    int tid, lane, wave, vcu, G;
    unsigned char* ws;
};
__device__ __forceinline__ int lane_id() { int l; asm volatile("v_mbcnt_lo_u32_b32 %0, -1, 0\n\tv_mbcnt_hi_u32_b32 %0, -1, %0" : "=v"(l)); return l; }
#define REFRESH(F) do { (F).lane = lane_id(); (F).tid = (F).wave * 64 + (F).lane; } while (0)
__device__ __forceinline__ float wave_sum(float v) {
#pragma unroll
    for (int o = 1; o < 64; o <<= 1) v += __shfl_xor(v, o);
    return v;
}

struct ConvItem { const float* W; unsigned char* WT; int K, N, ldk, mode, sub; float sc; };
__device__ __forceinline__ void cv_issue(const ConvItem& c, int lane, f32x4 (&ld)[8]) {
    const int nblk = c.N / 32, kb = c.sub / nblk, nb = c.sub % nblk, k0 = 64 * kb, n0 = 32 * nb, kq = lane & 7, nq = lane >> 3;
    const GAS float* src = (const GAS float*)c.W + (size_t)(k0 + 8 * kq) * c.N + n0 + 4 * nq;
#pragma unroll
    for (int i = 0; i < 8; ++i) ld[i] = *(const GAS f32x4*)(src + (size_t)i * c.N);
}
__device__ __forceinline__ void cv_finish_q8(const ConvItem& c, int lane, const f32x4 (&ld)[8]) {
    const int nblk = c.N / 32, kb = c.sub / nblk, nb = c.sub % nblk, k0 = 64 * kb, n0 = 32 * nb, kq = lane & 7, nq = lane >> 3;
    const int nn = n0 + 4 * nq, orow0 = c.mode == 0 ? nn : (((nn >> 7) << 8) + (c.mode == 2 ? 128 : 0) + (nn & 127));
    const float sc = c.sc;
    unsigned char* dst = c.WT + (size_t)orow0 * c.ldk + k0 + 8 * kq;
#pragma unroll
    for (int j = 0; j < 4; ++j) { v2u o; o.x = pg8::pk4_i8(ld[0][j] * sc, ld[1][j] * sc, ld[2][j] * sc, ld[3][j] * sc); o.y = pg8::pk4_i8(ld[4][j] * sc, ld[5][j] * sc, ld[6][j] * sc, ld[7][j] * sc);
        *(GAS v2u*)(dst + (size_t)j * c.ldk) = o; }
}
__device__ __forceinline__ void cv_finish_bf16(const ConvItem& c, int lane, const f32x4 (&ld)[8]) {
    const int nblk = c.N / 32, kb = c.sub / nblk, nb = c.sub % nblk, k0 = 64 * kb, n0 = 32 * nb, kq = lane & 7, nq = lane >> 3;
    const int nn = n0 + 4 * nq, orow0 = c.mode == 0 ? nn : (((nn >> 7) << 8) + (c.mode == 2 ? 128 : 0) + (nn & 127));
    bf16* dst = (bf16*)c.WT + (size_t)orow0 * c.ldk + k0 + 8 * kq;
#pragma unroll
    for (int j = 0; j < 4; ++j) { v4u o; o.x = pk2(ld[0][j], ld[1][j]); o.y = pk2(ld[2][j], ld[3][j]); o.z = pk2(ld[4][j], ld[5][j]); o.w = pk2(ld[6][j], ld[7][j]);
        *(GAS v4u*)(dst + (size_t)j * c.ldk) = o; }
}
__device__ __forceinline__ void cv128_issue(const ConvItem& c, int lane, f32x4 (&ld)[16]) {
    const int nblk = c.N / 32, kb = c.sub / nblk, nb = c.sub % nblk, k0 = 128 * kb, n0 = 32 * nb, kq = lane & 7, nq = lane >> 3;
    const GAS float* src = (const GAS float*)c.W + (size_t)(k0 + 16 * kq) * c.N + n0 + 4 * nq;
#pragma unroll
    for (int i = 0; i < 16; ++i) ld[i] = __builtin_nontemporal_load((const GAS f32x4*)(src + (size_t)i * c.N));
}
__device__ __forceinline__ void cv128_finish_q8(const ConvItem& c, int lane, const f32x4 (&ld)[16]) {
    const int nblk = c.N / 32, kb = c.sub / nblk, nb = c.sub % nblk, k0 = 128 * kb, n0 = 32 * nb, kq = lane & 7, nq = lane >> 3;
    const int nn = n0 + 4 * nq, orow0 = c.mode == 0 ? nn : (((nn >> 7) << 8) + (c.mode == 2 ? 128 : 0) + (nn & 127));
    const float sc = c.sc;
    unsigned char* dst = c.WT + (size_t)orow0 * c.ldk + k0 + 16 * kq;
#pragma unroll
    for (int j = 0; j < 4; ++j) { v4u o; o.x = pg8::pk4_i8(ld[0][j] * sc, ld[1][j] * sc, ld[2][j] * sc, ld[3][j] * sc); o.y = pg8::pk4_i8(ld[4][j] * sc, ld[5][j] * sc, ld[6][j] * sc, ld[7][j] * sc);
        o.z = pg8::pk4_i8(ld[8][j] * sc, ld[9][j] * sc, ld[10][j] * sc, ld[11][j] * sc); o.w = pg8::pk4_i8(ld[12][j] * sc, ld[13][j] * sc, ld[14][j] * sc, ld[15][j] * sc);
        __builtin_nontemporal_store(o, (GAS v4u*)(dst + (size_t)j * c.ldk)); }
}
__device__ __forceinline__ void p0_transpose_item(const float* W, int K, int N, bf16* WT, int item, int lane, int mode) {
    ConvItem c; c.W = W; c.WT = (unsigned char*)WT; c.K = K; c.N = N; c.ldk = K; c.mode = mode; c.sub = item; c.sc = 1.f;
    f32x4 ld[8]; cv_issue(c, lane, ld); cv_finish_bf16(c, lane, ld);
}
__device__ __forceinline__ void p0_transpose_item_q8(const float* W, int K, int N, unsigned char* WT, int ldk, int item, int lane, int mode, float sc) {
    ConvItem c; c.W = W; c.WT = WT; c.K = K; c.N = N; c.ldk = ldk; c.mode = mode; c.sub = item; c.sc = sc;
    f32x4 ld[8]; cv_issue(c, lane, ld); cv_finish_q8(c, lane, ld);
}
__device__ __forceinline__ void rms_row_to_bf16(const float* xrow, const float* gain, bf16* orow, int lane) {
    const GAS f32x4* xr = (const GAS f32x4*)xrow + lane; const GAS f32x4* gr = (const GAS f32x4*)gain + lane;
    f32x4 v[8]; float s = 0.f;
#pragma unroll
    for (int j = 0; j < 8; ++j) { v[j] = xr[64 * j]; s += (v[j].x * v[j].x + v[j].y * v[j].y) + (v[j].z * v[j].z + v[j].w * v[j].w); }
    const float r = 1.0f / sqrtf(wave_sum(s) * (1.f / D) + EPS);
    GAS v2u* o8 = (GAS v2u*)orow + lane;
#pragma unroll
    for (int j = 0; j < 8; ++j) { const f32x4 g = gr[64 * j]; v2u w; w.x = pk2(v[j].x * r * g.x, v[j].y * r * g.y); w.y = pk2(v[j].z * r * g.z, v[j].w * r * g.w); o8[64 * j] = w; }
}
__device__ __forceinline__ void rms_phase(Frame& F, const float* x, const float* gain, bf16* hn) {
    const int gw = F.vcu * NWAVES + F.wave, NGW = F.G * NWAVES;
    for (int m = gw; m < T; m += NGW) rms_row_to_bf16(x + (size_t)m * D, gain, hn + (size_t)m * D, F.lane);
}
__device__ __forceinline__ void rms_row_to_q8(const float* xrow, const float* gain, unsigned char* orow, float* rs, int lane) {
    const GAS f32x4* xr = (const GAS f32x4*)xrow + lane; const GAS f32x4* gr = (const GAS f32x4*)gain + lane;
    f32x4 v[8]; float s = 0.f, amax = 0.f;
#pragma unroll
    for (int j = 0; j < 8; ++j) { v[j] = xr[64 * j]; s += (v[j].x * v[j].x + v[j].y * v[j].y) + (v[j].z * v[j].z + v[j].w * v[j].w); const f32x4 g = gr[64 * j]; v[j] = v[j] * g;
        amax = fmaxf(amax, fmaxf(fmaxf(fabsf(v[j].x), fabsf(v[j].y)), fmaxf(fabsf(v[j].z), fabsf(v[j].w)))); }
    const float r = 1.0f / sqrtf(wave_sum(s) * (1.f / D) + EPS);
#pragma unroll
    for (int o = 1; o < 64; o <<= 1) amax = fmaxf(amax, __shfl_xor(amax, o));
    amax = fmaxf(amax * r, 1e-20f);
    const float rsv = __builtin_bit_cast(float, (__builtin_bit_cast(unsigned, amax * (1.0f / 127.0f)) + 0xFFFFu) & 0xFFFF0000u);
    const float qs = r / rsv;
    if (lane == 0) *rs = rsv;
    GAS unsigned* o4 = (GAS unsigned*)orow + lane;
#pragma unroll
    for (int j = 0; j < 8; ++j) o4[64 * j] = pg8::pk4_i8(v[j].x * qs, v[j].y * qs, v[j].z * qs, v[j].w * qs);
}
__device__ __forceinline__ void rms_phase_q8(Frame& F, const float* x, const float* gain) {
    const int gw = F.vcu * NWAVES + F.wave, NGW = F.G * NWAVES;
    for (int m = gw; m < T; m += NGW) rms_row_to_q8(x + (size_t)m * D, gain, F.ws + A_HN + (size_t)m * D, (float*)(F.ws + A_RSTOK) + m, F.lane);
}
constexpr int MOE_I = (D / 64) * (FE / 32), MOE_NITEMS = 3 * NE * MOE_I;
static_assert(MOE_I == (FE / 64) * (D / 32), "gate/up and down matrices have the same item count");
__device__ __forceinline__ ConvItem moe_item(Frame& F, int r) {
    ConvItem c; const int t = r / (NE * MOE_I), rr = r - t * (NE * MOE_I), e = rr / MOE_I; c.sub = rr - e * MOE_I;
    if (t < 2) { c.W = (t == 0 ? KARG->in[14] : KARG->in[15]) + (size_t)e * D * FE; c.K = D; c.N = FE; c.WT = F.ws + WS_W_MGU + (size_t)e * NMGU * D; c.ldk = D; c.mode = 1 + t; c.sc = Q_W2048; }
    else { c.W = KARG->in[16] + (size_t)e * FE * D; c.K = FE; c.N = D; c.WT = F.ws + WS_W_MDN + (size_t)e * D * FE; c.ldk = FE; c.mode = 0; c.sc = Q_W7168; }
    return c;
}
constexpr int ATT_NPAIR = 64 * 3 * 64 / 2;
#ifndef MK_ATT_CONV
#define MK_ATT_CONV 0
#endif
__device__ __forceinline__ int moe_split(int G) { if (!MK_ATT_CONV) return 0; const long n = (long)((ATT_NPAIR / G) * 3) * (G * NWAVES); return n < MOE_NITEMS ? (int)n : MOE_NITEMS; }
constexpr int MOE_I128 = MOE_I / 2, MOE_N128 = 3 * NE * MOE_I128;
#define MOE128(c_, r_) do { const int t = (r_) / (NE * MOE_I128), rr = (r_) - t * (NE * MOE_I128), e = rr / MOE_I128; c_.sub = rr - e * MOE_I128; \
            if (t < 2) { c_.W = (t == 0 ? KARG->in[14] : KARG->in[15]) + (size_t)e * D * FE; c_.K = D; c_.N = FE; c_.WT = F.ws + WS_W_MGU + (size_t)e * NMGU * D; c_.ldk = D; c_.mode = 1 + t; c_.sc = Q_W2048; } \
            else { c_.W = KARG->in[16] + (size_t)e * FE * D; c_.K = FE; c_.N = D; c_.WT = F.ws + WS_W_MDN + (size_t)e * D * FE; c_.ldk = FE; c_.mode = 0; c_.sc = Q_W7168; } } while (0)
__device__ __forceinline__ void p0_prologue(Frame& F) {
    const int gw = F.vcu * NWAVES + F.wave, NGW = F.G * NWAVES;
    constexpr int I_IN = (D / 64) * (N_IN / 32), I_SQ = (D / 64) * (D / 32), I_G = (D / 64) * (FFN / 32), I_DN = (FFN / 64) * (D / 32), I_QKV = (D / 64) * (NQKV / 32);
    constexpr int NITEMS = I_IN + 2 * I_SQ + 2 * I_G + I_DN + I_QKV + MOE_NITEMS;
    for (int it = gw; it < NITEMS; it += NGW) {
        int r = it;
        if (r < I_IN) { p0_transpose_item_q8((KARG->in[2]), D, N_IN, (F.ws + WS_W_IN), D, r, F.lane, 0, Q_W2048); continue; } r -= I_IN;
        if (r < I_SQ) { p0_transpose_item((KARG->in[5]), D, D, ((bf16*)(F.ws + WS_W_HO)), r, F.lane, 0); continue; } r -= I_SQ;
        if (r < I_G) { p0_transpose_item_q8((KARG->in[10]), D, FFN, (F.ws + WS_W_GU), D, r, F.lane, 1, Q_W2048); continue; } r -= I_G;
        if (r < I_G) { p0_transpose_item_q8((KARG->in[11]), D, FFN, (F.ws + WS_W_GU), D, r, F.lane, 2, Q_W2048); continue; } r -= I_G;
        if (r < I_DN) { p0_transpose_item_q8((KARG->in[12]), FFN, D, (F.ws + WS_W_DN), FFNP, r, F.lane, 0, Q_W5504); continue; } r -= I_DN;
        if (r < I_QKV) { p0_transpose_item_q8((KARG->in[6]), D, NQKV, (F.ws + WS_W_QKV), D, r, F.lane, 0, Q_W2048); continue; } r -= I_QKV;
        if (r < I_SQ) { p0_transpose_item_q8((KARG->in[9]), D, D, (F.ws + WS_W_AO), D, r, F.lane, 0, Q_W2048); continue; } r -= I_SQ;
        if (MK_ATT_CONV) { const int rm = r + moe_split(F.G); if (rm < MOE_NITEMS) { const ConvItem c = moe_item(F, rm); f32x4 ld[8]; cv_issue(c, F.lane, ld); cv_finish_q8(c, F.lane, ld); } }
        else break;
    }
    { const int gt = (F.vcu * NWAVES + F.wave) * 64 + F.lane, NT = F.G * NWAVES * 64;
      for (int i = gt; i < D * ((FFNP - FFN) / 16); i += NT) { const int n = i / ((FFNP - FFN) / 16), j = i % ((FFNP - FFN) / 16); *(GAS v4u*)(F.ws + WS_W_DN + (size_t)n * FFNP + FFN + j * 16) = (v4u){0u, 0u, 0u, 0u}; }
    }
    { const int gt = (F.vcu * NWAVES + F.wave) * 64 + F.lane, NT = F.G * NWAVES * 64;
      for (int i = gt; i < 256 * D / 16; i += NT) *(GAS v4u*)(F.ws + WS_W_GU + (size_t)NGU * D + (size_t)i * 16) = (v4u){0u, 0u, 0u, 0u};
    }
    rms_phase_q8(F, (KARG->in[0]), (KARG->in[1]));
}

constexpr int SC_QP = 272, SC_VP = 144;
constexpr int SC_QS = 0, SC_KS = 17408, SC_VS = 34816, SC_AT = 44032, SC_EG = 53248, SC_SL = 53760, SC_TOT = 71168, SC_END = 75264;
static_assert(SC_KS == 64 * SC_QP && SC_VS == SC_KS + 64 * SC_QP && SC_AT == SC_VS + 64 * SC_VP && SC_EG == SC_AT + 64 * SC_VP && SC_SL == SC_EG + 512 && SC_TOT == SC_SL + 64 * SC_QP && SC_END == SC_TOT + 4096, "scan LDS map");
static_assert(4 * SC_QP == 1088 && 32 * SC_QP == 8704 && 4 * SC_VP == 576 && 32 * SC_VP == 4608, "immediates in the transposed-read asm");
__device__ __forceinline__ void scan_phase(Frame& F) {
    LAS unsigned char* lds = F.lds;
    const unsigned ldsb = (unsigned)(size_t)lds;
    const int tid = F.tid, lane = F.lane, w = F.wave, l15 = lane & 15, g = lane >> 4;
    const int kp = tid & 63, rq = tid >> 6, vr = tid >> 3, vc = tid & 7;
    const unsigned q4 = (unsigned)l15 >> 2, p4 = (unsigned)lane & 3u;
    const int vt = w & 3, ip = w >> 2;
    const bf16* proj = ((bf16*)(F.ws + A_BIG));
    for (int unit = blockIdx.x; unit < 256; unit += F.G) {
        const int half = unit & 1, dir = (unit >> 1) & 1, h = (unit >> 2) & 15, b = unit >> 6;
        float lbk0, lbk1;
        { const int col = h * 128 + 2 * kp;
          const f32x2 l0 = *(const f32x2*)((KARG->in[3]) + (0 * 2 + dir) * 2048 + col), l1 = *(const f32x2*)((KARG->in[3]) + (1 * 2 + dir) * 2048 + col), l2 = *(const f32x2*)((KARG->in[3]) + (2 * 2 + dir) * 2048 + col);
          { const float mx = fmaxf(l0.x, fmaxf(l1.x, l2.x)); const float e0 = expf(l0.x - mx), e1 = expf(l1.x - mx), e2 = expf(l2.x - mx); lbk0 = e0 / (e0 + e1 + e2); }
          { const float mx = fmaxf(l0.y, fmaxf(l1.y, l2.y)); const float e0 = expf(l0.y - mx), e1 = expf(l1.y - mx), e2 = expf(l2.y - mx); lbk1 = e0 / (e0 + e1 + e2); } }
        const bf16* pb = proj + (size_t)(b * SEQ) * N_IN;
        const int qcol = h * 128 + 2 * kp, fcol = 2048 * (1 + dir) + h * 128 + 2 * kp, vcol = 6144 + h * 128 + half * 64 + vc * 8;
        bf16* obase = ((bf16*)(F.ws + A_OF)) + (size_t)dir * T * D + (size_t)(b * SEQ) * D + h * 128 + half * 64;
        for (int i = tid; i < (64 * SC_VP) / 16; i += NTHREADS) *(LAS v4u*)(lds + SC_AT + i * 16) = (v4u){0u, 0u, 0u, 0u};
        for (int i = tid; i < (64 * SC_QP) / 16; i += NTHREADS) *(LAS v4u*)(lds + SC_SL + i * 16) = (v4u){0u, 0u, 0u, 0u};
        f32x4 S[4];
#pragma unroll
        for (int i = 0; i < 4; ++i) S[i] = (f32x4){0.f, 0.f, 0.f, 0.f};
        unsigned rawq[8], rawf[8]; v4u rawv, vcur;
        float qs0[8], qs1[8], kk0[8], kk1[8], cc0[8], cc1[8];
#define SCAN_TOK(c, tt) (dir ? (SEQ - 1 - ((c) * 64 + (tt))) : ((c) * 64 + (tt)))
#define SC2_LOAD(c) do { _Pragma("unroll") for (int i = 0; i < 8; ++i) { const size_t ro = (size_t)SCAN_TOK(c, 8 * rq + i) * N_IN; rawq[i] = *(const GAS unsigned*)(pb + ro + qcol); rawf[i] = *(const GAS unsigned*)(pb + ro + fcol); } \
        rawv = *(const GAS v4u*)(pb + (size_t)SCAN_TOK(c, vr) * N_IN + vcol); } while (0)
#define SC2_B0A() do { float run0 = 1.f, run1 = 1.f; _Pragma("unroll") for (int i = 0; i < 8; ++i) { \
            const float f0 = lbk0 + (1.0f - lbk0) * bflo(rawf[i]), f1 = lbk1 + (1.0f - lbk1) * bfhi(rawf[i]); kk0[i] = 1.0f - f0; kk1[i] = 1.0f - f1; \
            run0 *= f0; run1 *= f1; cc0[i] = run0; cc1[i] = run1; qs0[i] = bflo(rawq[i]); qs1[i] = bfhi(rawq[i]); } \
        { f32x2 rr; rr.x = run0; rr.y = run1; *(LAS f32x2*)(lds + SC_TOT + (rq * 128 + 2 * kp) * 4) = rr; } vcur = rawv; } while (0)
#define SC2_B0B() do { float base0 = 1.f, base1 = 1.f; _Pragma("unroll") for (int r = 0; r < 7; ++r) { const f32x2 tv = *(const LAS f32x2*)(lds + SC_TOT + (r * 128 + 2 * kp) * 4); if (r < rq) { base0 *= tv.x; base1 *= tv.y; } } \
        _Pragma("unroll") for (int i = 0; i < 8; ++i) { const float eg0 = base0 * cc0[i], eg1 = base1 * cc1[i]; \
            const float ek0 = __builtin_amdgcn_rcpf(fmaxf(eg0, 1.8e-35f)), ek1 = __builtin_amdgcn_rcpf(fmaxf(eg1, 1.8e-35f));        \
            *(LAS unsigned*)(lds + SC_QS + (8 * rq + i) * SC_QP + kp * 4) = pg8::cvt_pk_bf16(qs0[i] * eg0, qs1[i] * eg1); \
            *(LAS unsigned*)(lds + SC_KS + (8 * rq + i) * SC_QP + kp * 4) = pg8::cvt_pk_bf16(kk0[i] * ek0, kk1[i] * ek1); } \
        if (rq == 7) { f32x2 ev; ev.x = base0 * cc0[7]; ev.y = base1 * cc1[7]; *(LAS f32x2*)(lds + SC_EG + 2 * kp * 4) = ev; } \
        *(LAS v4u*)(lds + SC_VS + vr * SC_VP + vc * 16) = vcur; } while (0)
        SC2_LOAD(0);
        SC2_B0A();
        SC2_LOAD(1);
        __syncthreads();
        SC2_B0B();
        for (int c = 0; c < 64; ++c) {
            __syncthreads();
            for (int ti = w; ti < 10; ti += 8) {
                int J, I; if (ti < 4) { J = ti; I = ti; } else if (ti < 7) { J = ti - 4; I = J + 1; } else if (ti < 9) { J = ti - 7; I = J + 2; } else { J = 0; I = 3; }
                f32x4 acc = (f32x4){0.f, 0.f, 0.f, 0.f};
#pragma unroll
                for (int s4 = 0; s4 < 4; ++s4) { const bf16x8 kf = *(const LAS bf16x8*)(lds + SC_KS + (16 * J + l15) * SC_QP + (32 * s4 + 8 * g) * 2);
                    const bf16x8 qf = *(const LAS bf16x8*)(lds + SC_QS + (16 * I + l15) * SC_QP + (32 * s4 + 8 * g) * 2);
                    acc = __builtin_amdgcn_mfma_f32_16x16x32_bf16(kf, qf, acc, 0, 0, 0); }
                if (J == I) {
#pragma unroll
                    for (int e = 0; e < 4; ++e) if (4 * g + e > l15) acc[e] = 0.f; }
                v2u wv; wv.x = pk2(acc[0], acc[1]); wv.y = pk2(acc[2], acc[3]);
                *(LAS v2u*)(lds + SC_AT + (16 * I + l15) * SC_VP + (16 * J + 4 * g) * 2) = wv;
            }
            f32x4 U[4];
            {
                const unsigned ka = ldsb + SC_KS + (8u * g + q4) * SC_QP + (16u * w + 4u * p4) * 2u;
                const unsigned va = ldsb + SC_VS + (8u * g + q4) * SC_VP + p4 * 8u;
                v2u kr[4], vv[16];
                asm volatile(
                    "ds_read_b64_tr_b16 %0, %20 offset:0\n\tds_read_b64_tr_b16 %1, %20 offset:1088\n\tds_read_b64_tr_b16 %2, %20 offset:8704\n\tds_read_b64_tr_b16 %3, %20 offset:9792\n\t"
                    "ds_read_b64_tr_b16 %4, %21 offset:0\n\tds_read_b64_tr_b16 %5, %21 offset:576\n\tds_read_b64_tr_b16 %6, %21 offset:4608\n\tds_read_b64_tr_b16 %7, %21 offset:5184\n\t"
                    "ds_read_b64_tr_b16 %8, %21 offset:32\n\tds_read_b64_tr_b16 %9, %21 offset:608\n\tds_read_b64_tr_b16 %10, %21 offset:4640\n\tds_read_b64_tr_b16 %11, %21 offset:5216\n\t"
                    "ds_read_b64_tr_b16 %12, %21 offset:64\n\tds_read_b64_tr_b16 %13, %21 offset:640\n\tds_read_b64_tr_b16 %14, %21 offset:4672\n\tds_read_b64_tr_b16 %15, %21 offset:5248\n\t"
                    "ds_read_b64_tr_b16 %16, %21 offset:96\n\tds_read_b64_tr_b16 %17, %21 offset:672\n\tds_read_b64_tr_b16 %18, %21 offset:4704\n\tds_read_b64_tr_b16 %19, %21 offset:5280\n\t"
                    "s_waitcnt lgkmcnt(0)"
                    : "=&v"(kr[0]), "=&v"(kr[1]), "=&v"(kr[2]), "=&v"(kr[3]),
                      "=&v"(vv[0]), "=&v"(vv[1]), "=&v"(vv[2]), "=&v"(vv[3]), "=&v"(vv[4]), "=&v"(vv[5]), "=&v"(vv[6]), "=&v"(vv[7]),
                      "=&v"(vv[8]), "=&v"(vv[9]), "=&v"(vv[10]), "=&v"(vv[11]), "=&v"(vv[12]), "=&v"(vv[13]), "=&v"(vv[14]), "=&v"(vv[15])
                    : "v"(ka), "v"(va) : "memory");
#pragma unroll
                for (int j = 0; j < 4; ++j) U[j] = (f32x4){0.f, 0.f, 0.f, 0.f};
#pragma unroll
                for (int ks = 0; ks < 2; ++ks) { union { bf16x8 v; unsigned u[4]; } kf; kf.u[0] = kr[2 * ks].x; kf.u[1] = kr[2 * ks].y; kf.u[2] = kr[2 * ks + 1].x; kf.u[3] = kr[2 * ks + 1].y;
#pragma unroll
                    for (int j = 0; j < 4; ++j) { union { bf16x8 v; unsigned u[4]; } vf; vf.u[0] = vv[4 * j + 2 * ks].x; vf.u[1] = vv[4 * j + 2 * ks].y; vf.u[2] = vv[4 * j + 2 * ks + 1].x; vf.u[3] = vv[4 * j + 2 * ks + 1].y;
                        U[j] = __builtin_amdgcn_mfma_f32_16x16x32_bf16(kf.v, vf.v, U[j], 0, 0, 0); } }
            }
            f32x4 oacc[2];
            oacc[0] = (f32x4){0.f, 0.f, 0.f, 0.f}; oacc[1] = (f32x4){0.f, 0.f, 0.f, 0.f};
#pragma unroll
            for (int s4 = 0; s4 < 4; ++s4) { const bf16x8 sf = *(const LAS bf16x8*)(lds + SC_SL + (16 * vt + l15) * SC_QP + (32 * s4 + 8 * g) * 2);
#pragma unroll
                for (int ii = 0; ii < 2; ++ii) { const bf16x8 qf = *(const LAS bf16x8*)(lds + SC_QS + (16 * (2 * ip + ii) + l15) * SC_QP + (32 * s4 + 8 * g) * 2);
                    oacc[ii] = __builtin_amdgcn_mfma_f32_16x16x32_bf16(sf, qf, oacc[ii], 0, 0, 0); } }
            __syncthreads();
            {
                const unsigned va2 = ldsb + SC_VS + (8u * g + q4) * SC_VP + p4 * 8u + (unsigned)vt * 32u;
                v2u vr4[4];
                asm volatile("ds_read_b64_tr_b16 %0, %4 offset:0\n\tds_read_b64_tr_b16 %1, %4 offset:576\n\tds_read_b64_tr_b16 %2, %4 offset:4608\n\tds_read_b64_tr_b16 %3, %4 offset:5184\n\ts_waitcnt lgkmcnt(0)"
                    : "=&v"(vr4[0]), "=&v"(vr4[1]), "=&v"(vr4[2]), "=&v"(vr4[3]) : "v"(va2) : "memory");
                union { bf16x8 v; unsigned u[4]; } v0, v1; v0.u[0] = vr4[0].x; v0.u[1] = vr4[0].y; v0.u[2] = vr4[1].x; v0.u[3] = vr4[1].y; v1.u[0] = vr4[2].x; v1.u[1] = vr4[2].y; v1.u[2] = vr4[3].x; v1.u[3] = vr4[3].y;
#pragma unroll
                for (int ii = 0; ii < 2; ++ii) { const int I = 2 * ip + ii;
                    const bf16x8 a0 = *(const LAS bf16x8*)(lds + SC_AT + (16 * I + l15) * SC_VP + (8 * g) * 2);
                    oacc[ii] = __builtin_amdgcn_mfma_f32_16x16x32_bf16(v0.v, a0, oacc[ii], 0, 0, 0);
                    if (ip == 1) { const bf16x8 a1 = *(const LAS bf16x8*)(lds + SC_AT + (16 * I + l15) * SC_VP + (32 + 8 * g) * 2);
                        oacc[ii] = __builtin_amdgcn_mfma_f32_16x16x32_bf16(v1.v, a1, oacc[ii], 0, 0, 0); }
                    v2u wv; wv.x = pk2(oacc[ii][0], oacc[ii][1]); wv.y = pk2(oacc[ii][2], oacc[ii][3]);
                    *(GAS v2u*)(obase + (size_t)SCAN_TOK(c, 16 * I + l15) * D + 16 * vt + 4 * g) = wv; }
            }
            { const f32x4 eg = *(const LAS f32x4*)(lds + SC_EG + (16 * w + 4 * g) * 4);
#pragma unroll
              for (int j = 0; j < 4; ++j) { S[j] = eg * (S[j] + U[j]);
                  v2u wv; wv.x = pk2(S[j][0], S[j][1]); wv.y = pk2(S[j][2], S[j][3]);
                  *(LAS v2u*)(lds + SC_SL + (16 * j + l15) * SC_QP + (16 * w + 4 * g) * 2) = wv; } }
            if (c + 1 < 64) { SC2_B0A(); if (c + 2 < 64) SC2_LOAD(c + 2); }
            __syncthreads();
            if (c + 1 < 64) SC2_B0B();
        }
        __syncthreads();
#undef SCAN_TOK
#undef SC2_LOAD
#undef SC2_B0A
#undef SC2_B0B
    }
}

__device__ __forceinline__ void onorm_phase(Frame& F) {
    const int gw = F.vcu * NWAVES + F.wave, NGW = F.G * NWAVES, lane = F.lane;
    const bf16* proj = ((bf16*)(F.ws + A_BIG));
    for (int m = gw; m < T; m += NGW) {
        v4u as_[4], bs_[4], gs_[4];
#pragma unroll
        for (int pass = 0; pass < 4; ++pass) { const int c0 = (pass * 64 + lane) * 8;
            as_[pass] = *(const GAS v4u*)(((bf16*)(F.ws + A_OF)) + (size_t)m * D + c0); bs_[pass] = *(const GAS v4u*)(((bf16*)(F.ws + A_OF)) + (size_t)T * D + (size_t)m * D + c0);
            gs_[pass] = *(const GAS v4u*)(proj + (size_t)m * N_IN + 8192 + c0); }
#pragma unroll
        for (int pass = 0; pass < 4; ++pass) {
            const int c0 = (pass * 64 + lane) * 8;
            const v4u a = as_[pass], bq = bs_[pass];
            const v4u gt = gs_[pass];
            const f32x4 g0 = *(const GAS f32x4*)((KARG->in[4]) + c0), g1 = *(const GAS f32x4*)((KARG->in[4]) + c0 + 4);
            const unsigned aw[4] = {a.x, a.y, a.z, a.w}, bw[4] = {bq.x, bq.y, bq.z, bq.w}, gw4[4] = {gt.x, gt.y, gt.z, gt.w};
            const float gn[8] = {g0.x, g0.y, g0.z, g0.w, g1.x, g1.y, g1.z, g1.w};
            float o[8], ss = 0.f;
#pragma unroll
            for (int j = 0; j < 4; ++j) { o[2 * j] = bflo(aw[j]) + bflo(bw[j]); o[2 * j + 1] = bfhi(aw[j]) + bfhi(bw[j]); ss += o[2 * j] * o[2 * j] + o[2 * j + 1] * o[2 * j + 1]; }
            ss += __shfl_xor(ss, 1); ss += __shfl_xor(ss, 2); ss += __shfl_xor(ss, 4); ss += __shfl_xor(ss, 8);
            const float r = 1.0f / sqrtf(ss * (1.f / 128.f) + EPS);
            float y[8];
#pragma unroll
            for (int j = 0; j < 4; ++j) { const float t0 = bflo(gw4[j]), t1 = bfhi(gw4[j]);
                y[2 * j] = o[2 * j] * r * gn[2 * j] * (t0 * __builtin_amdgcn_rcpf(1.0f + __expf(-t0)));
                y[2 * j + 1] = o[2 * j + 1] * r * gn[2 * j + 1] * (t1 * __builtin_amdgcn_rcpf(1.0f + __expf(-t1))); }
            v4u w; w.x = pk2(y[0], y[1]); w.y = pk2(y[2], y[3]); w.z = pk2(y[4], y[5]); w.w = pk2(y[6], y[7]);
            *(GAS v4u*)(((bf16*)(F.ws + A_OB)) + (size_t)m * D + c0) = w;
        }
    }
}

__device__ __forceinline__ void qknorm_rope_phase(Frame& F) {
    const int gw = F.vcu * NWAVES + F.wave, NGW = F.G * NWAVES, lane = F.lane, hs = lane >> 4, i4 = lane & 15;
    bf16* qkv = ((bf16*)(F.ws + A_BIG));
    float inv[4], qg1[4], qg2[4], kg1[4], kg2[4];
#pragma unroll
    for (int e = 0; e < 4; ++e) { inv[e] = expf(-(float)(4 * i4 + e) * (2.0f / 128.0f) * 9.210340371976184f) * 0.15915494309189535f;
        qg1[e] = (KARG->in[7])[4 * i4 + e]; qg2[e] = (KARG->in[7])[64 + 4 * i4 + e]; kg1[e] = (KARG->in[8])[4 * i4 + e]; kg2[e] = (KARG->in[8])[64 + 4 * i4 + e]; }
    for (int m = gw; m < T; m += NGW) {
        const float pos = (float)(m & (SEQ - 1));
        float sn[4], cs[4];
#pragma unroll
        for (int e = 0; e < 4; ++e) { float rev = pos * inv[e]; rev -= floorf(rev); sn[e] = __builtin_amdgcn_sinf(rev); cs[e] = __builtin_amdgcn_cosf(rev); }
        bf16* rowp = qkv + (size_t)m * NQKV + hs * 128 + 4 * i4;
        v2u ras[8], rbs[8];
#pragma unroll
        for (int p = 0; p < 8; ++p) { const bf16* base = rowp + (p < 4 ? 0 : 2048) + (p & 3) * 512; ras[p] = *(const GAS v2u*)base; rbs[p] = *(const GAS v2u*)(base + 64); }
#pragma unroll
        for (int p = 0; p < 8; ++p) {
            const bool isq = p < 4; bf16* base = rowp + (isq ? 0 : 2048) + (p & 3) * 512;
            const v2u ra = ras[p], rb = rbs[p];
            const float x1[4] = {bflo(ra.x), bfhi(ra.x), bflo(ra.y), bfhi(ra.y)}, x2[4] = {bflo(rb.x), bfhi(rb.x), bflo(rb.y), bfhi(rb.y)};
            float ss = (x1[0] * x1[0] + x1[1] * x1[1]) + (x1[2] * x1[2] + x1[3] * x1[3]) + (x2[0] * x2[0] + x2[1] * x2[1]) + (x2[2] * x2[2] + x2[3] * x2[3]);
            ss += __shfl_xor(ss, 1); ss += __shfl_xor(ss, 2); ss += __shfl_xor(ss, 4); ss += __shfl_xor(ss, 8);
            const float r = (1.0f / sqrtf(ss * (1.f / 128.f) + EPS)) * (isq ? 0.12751743075f : 1.0f);
            float o1[4], o2[4];
#pragma unroll
            for (int e = 0; e < 4; ++e) { const float y1 = x1[e] * r * (isq ? qg1[e] : kg1[e]), y2 = x2[e] * r * (isq ? qg2[e] : kg2[e]); o1[e] = y1 * cs[e] - y2 * sn[e]; o2[e] = y2 * cs[e] + y1 * sn[e]; }
            v2u wa, wb; wa.x = pk2(o1[0], o1[1]); wa.y = pk2(o1[2], o1[3]); wb.x = pk2(o2[0], o2[1]); wb.y = pk2(o2[2], o2[3]);
            *(GAS v2u*)base = wa; *(GAS v2u*)(base + 64) = wb;
        }
    }
}

constexpr int ATT_KP = 272;
constexpr int ATT_GRP_BYTES = 2 * 64 * ATT_KP;
__device__ __forceinline__ void attn_phase(Frame& F) {
    const int tid = F.tid, lane = F.lane, w = F.wave, qi = w & 3, gtid = tid & 255;
    const int l15 = lane & 15, g = lane >> 4;
    LAS unsigned char* Kbase = F.lds;
    const bf16* qkv = ((bf16*)(F.ws + A_BIG));
    bf16* obr = ((bf16*)(F.ws + A_OF)); float* lse = ((float*)(F.ws + A_LSE));
    constexpr int NPAIR = ATT_NPAIR;
    const int per = (NPAIR + F.G - 1) / F.G, p_lo = F.vcu * per, p_hi = (p_lo + per < NPAIR) ? p_lo + per : NPAIR;
    const int nit = (p_hi > p_lo) ? (p_hi - p_lo) * 6 : 0;
    v4u R0[8], R1[8]; bf16x8 Qn0[4], Qn1[4], Qh[4];
    int b = 0, h = 0, br = 0, r = 1, n = SEQ, cls = 0, nb = 0;
    bf16x8 Qf[4]; f32x4 Ot[8]; float mrow = -1e29f, lrow = 0.f;
    for (int s4 = 0; s4 < 4; ++s4) { Qn0[s4] = (bf16x8){0, 0, 0, 0, 0, 0, 0, 0}; Qn1[s4] = Qn0[s4]; }
#define ATT_UNIT(it_) do { const int uid = 2 * p_lo + (it_) / 3; const int bh = uid / 192, rem = uid - bh * 192; br = rem >> 6; const int idx = rem & 63; \
        b = bh >> 4; h = bh & 15; r = 1 << (2 * br); n = SEQ >> (2 * br); const int sh = 6 - 2 * br; cls = idx >> sh; nb = idx & ((1 << sh) - 1); } while (0)
#define ATT_PREFETCH(it_, R, Qn) do { int b_, h_, r_, n_, cls_, nb_; { const int uid = 2 * p_lo + (it_) / 3; const int bh = uid / 192, rem = uid - bh * 192; const int br_ = rem >> 6, idx = rem & 63; \
            b_ = bh >> 4; h_ = bh & 15; r_ = 1 << (2 * br_); n_ = SEQ >> (2 * br_); const int sh = 6 - 2 * br_; cls_ = idx >> sh; nb_ = idx & ((1 << sh) - 1); } \
        const int kp0 = 64 * (nb_ - 1 + (it_) % 3), kp0c = kp0 < 0 ? 0 : (kp0 >= n_ ? n_ - 64 : kp0);     \
        const GAS char* kbase = (const GAS char*)qkv + ((size_t)(b_ * SEQ + cls_ + r_ * kp0c) * NQKV + 2048 + h_ * 128) * 2; \
        const GAS char* qbase = (const GAS char*)qkv + ((size_t)(b_ * SEQ + cls_ + r_ * 64 * nb_) * NQKV + h_ * 128) * 2; \
        const unsigned rstride = (unsigned)r_ * (NQKV * 2); \
          \
        if (((it_) % 3 == 2) || ((it_) < 3) || (nb_ == 0)) { _Pragma("unroll") for (int i = 0; i < 4; ++i) { const unsigned voff = (unsigned)((gtid >> 4) + 16 * i) * rstride + (unsigned)(gtid & 15) * 16u; R[i] = *(const GAS v4u*)(kbase + voff); R[4 + i] = *(const GAS v4u*)(kbase + voff + 4096u); } } \
        if ((it_) % 3 == 0) { const unsigned voffq = (unsigned)(16 * qi + l15) * rstride + 16u * g; \
            _Pragma("unroll") for (int s4 = 0; s4 < 4; ++s4) Qn[s4] = *(const GAS bf16x8*)(qbase + voffq + 64u * s4); } } while (0)
#pragma unroll
    for (int s4 = 0; s4 < 4; ++s4) Qh[s4] = Qn0[s4];
    __syncthreads();
    if (w >= 4) {
        const int cw = F.vcu * 4 + (w - 4), CN = F.G * 4;
        const int nmine = cw < MOE_N128 ? (MOE_N128 - cw + CN - 1) / CN : 0;
        f32x4 la[16], lb[16], lc[16]; ConvItem ca;
        if (nmine > 0) { MOE128(ca, cw); cv128_issue(ca, lane, la); }
        if (nmine > 1) { MOE128(ca, cw + CN); cv128_issue(ca, lane, lb); }
        if (nmine > 2) { MOE128(ca, cw + 2 * CN); cv128_issue(ca, lane, lc); }
        __builtin_amdgcn_s_barrier();
#define ATT_CSTEP(buf_, j_) do { const int r_ = cw + (j_) * CN; MOE128(ca, r_); cv128_finish_q8(ca, lane, buf_); if ((j_) + 3 < nmine) { MOE128(ca, r_ + 3 * CN); cv128_issue(ca, lane, buf_); } } while (0)
        for (int j = 0; j < nmine; j += 3) {
            ATT_CSTEP(la, j);
            if (j + 1 < nmine) ATT_CSTEP(lb, j + 1);
            if (j + 2 < nmine) ATT_CSTEP(lc, j + 2);
        }
#undef ATT_CSTEP
        return;
    }
    volatile LAS unsigned* aflag = (volatile LAS unsigned*)(F.lds + 4 * ATT_GRP_BYTES);
    if (lane == 0) aflag[qi] = 0u;
    __builtin_amdgcn_s_setprio(3);
    if (nit > 0) {
        ATT_PREFETCH(0, R0, Qn0);
#pragma unroll
        for (int i = 0; i < 4; ++i) { const int idx = gtid + 256 * i, row = idx >> 4, ch = idx & 15; *(LAS v4u*)(Kbase + row * ATT_KP + ch * 16) = R0[i]; *(LAS v4u*)(Kbase + 64 * ATT_KP + row * ATT_KP + ch * 16) = R0[4 + i]; }
#pragma unroll
        for (int s4 = 0; s4 < 4; ++s4) Qh[s4] = Qn0[s4];
        { const int i1 = nit > 1 ? 1 : 0; ATT_PREFETCH(i1, R1, Qn1); }
        { const int i2 = nit > 2 ? 2 : nit - 1; ATT_PREFETCH(i2, R0, Qn0); }
    }
    __syncthreads();
    int sbase = 0;
    for (int it = 0; it < nit; ++it) {
        const int kb = it % 3;
        if (kb == 0) {
            ATT_UNIT(it);
            if (it > 0) sbase += (nb == 0) ? 3 : 1;
#pragma unroll
            for (int s4 = 0; s4 < 4; ++s4) Qf[s4] = Qh[s4];
#pragma unroll
            for (int c = 0; c < 8; ++c) Ot[c] = (f32x4){0.f, 0.f, 0.f, 0.f};
            mrow = -1e29f; lrow = 0.f;
        }
        LAS unsigned char* Kl = Kbase + ((sbase + kb) & 3) * ATT_GRP_BYTES; LAS unsigned char* Vl = Kl + 64 * ATT_KP;
        bool fresh_n; int slot_n;
        if (kb < 2) { slot_n = (sbase + kb + 1) & 3; fresh_n = (kb == 1) || (it < 3) || (nb == 0); }
        else { const int uidn = 2 * p_lo + it / 3 + 1, remn = uidn % 192, shn = 6 - 2 * (remn >> 6), nbn = (remn & 63) & ((1 << shn) - 1);
               const bool fs = (nbn == 0); slot_n = (sbase + (fs ? 3 : 1)) & 3; fresh_n = fs && (it + 1 < nit); }
        LAS unsigned char* Kn = Kbase + slot_n * ATT_GRP_BYTES;
#define ATT_STAGE(R, Qn) do { if (fresh_n) { _Pragma("unroll") for (int i = 0; i < 4; ++i) { const int idx = gtid + 256 * i, row = idx >> 4, ch = idx & 15; *(LAS v4u*)(Kn + row * ATT_KP + ch * 16) = R[i]; *(LAS v4u*)(Kn + 64 * ATT_KP + row * ATT_KP + ch * 16) = R[4 + i]; } } \
            if ((it + 1) % 3 == 0) { _Pragma("unroll") for (int s4 = 0; s4 < 4; ++s4) Qh[s4] = Qn[s4]; } \
            { const int itn = (it + 3 < nit) ? it + 3 : nit - 1; ATT_PREFETCH(itn, R, Qn); } } while (0)
        if (it & 1) ATT_STAGE(R0, Qn0); else ATT_STAGE(R1, Qn1);
#undef ATT_STAGE
        const int pq = 64 * nb + 16 * qi + l15, kp0 = 64 * (nb - 1 + kb);
        f32x4 sc[4];
        { const unsigned ka = (unsigned)(size_t)Kl + (unsigned)l15 * ATT_KP + 16u * g;
          static_assert(16 * ATT_KP == 4352, "immediates in the K fragment read asm");
#pragma unroll
          for (int half = 0; half < 2; ++half) {
              bf16x8 kf[8];
              const unsigned kb2 = ka + (unsigned)half * 2u * 4352u;
              asm volatile("ds_read_b128 %0, %8 offset:0\n\tds_read_b128 %1, %8 offset:64\n\tds_read_b128 %2, %8 offset:128\n\tds_read_b128 %3, %8 offset:192\n\t"
                           "ds_read_b128 %4, %8 offset:4352\n\tds_read_b128 %5, %8 offset:4416\n\tds_read_b128 %6, %8 offset:4480\n\tds_read_b128 %7, %8 offset:4544\n\ts_waitcnt lgkmcnt(0)"
                           : "=&v"(kf[0]), "=&v"(kf[1]), "=&v"(kf[2]), "=&v"(kf[3]), "=&v"(kf[4]), "=&v"(kf[5]), "=&v"(kf[6]), "=&v"(kf[7]) : "v"(kb2) : "memory");
#pragma unroll
              for (int k2 = 0; k2 < 2; ++k2) { const int kt = 2 * half + k2; sc[kt] = (f32x4){0.f, 0.f, 0.f, 0.f};
#pragma unroll
                  for (int s4 = 0; s4 < 4; ++s4) sc[kt] = __builtin_amdgcn_mfma_f32_16x16x32_bf16(kf[4 * k2 + s4], Qf[s4], sc[kt], 0, 0, 0); } } }
        const unsigned q4 = (unsigned)l15 >> 2, p4 = (unsigned)lane & 3u;
        const unsigned va = (unsigned)(size_t)Vl + (4u * g + q4) * ATT_KP + p4 * 8u;
        v2u t0[8], t1[8];
#define ATT_VREAD(va_, tail_) asm volatile( \
                "ds_read_b64_tr_b16 %0, %16 offset:0\n\tds_read_b64_tr_b16 %1, %16 offset:32\n\tds_read_b64_tr_b16 %2, %16 offset:64\n\tds_read_b64_tr_b16 %3, %16 offset:96\n\t" \
                "ds_read_b64_tr_b16 %4, %16 offset:128\n\tds_read_b64_tr_b16 %5, %16 offset:160\n\tds_read_b64_tr_b16 %6, %16 offset:192\n\tds_read_b64_tr_b16 %7, %16 offset:224\n\t" \
                "ds_read_b64_tr_b16 %8, %17 offset:0\n\tds_read_b64_tr_b16 %9, %17 offset:32\n\tds_read_b64_tr_b16 %10, %17 offset:64\n\tds_read_b64_tr_b16 %11, %17 offset:96\n\t" \
                "ds_read_b64_tr_b16 %12, %17 offset:128\n\tds_read_b64_tr_b16 %13, %17 offset:160\n\tds_read_b64_tr_b16 %14, %17 offset:192\n\tds_read_b64_tr_b16 %15, %17 offset:224\n\t" \
                tail_ \
                : "=&v"(t0[0]), "=&v"(t0[1]), "=&v"(t0[2]), "=&v"(t0[3]), "=&v"(t0[4]), "=&v"(t0[5]), "=&v"(t0[6]), "=&v"(t0[7]), \
                  "=&v"(t1[0]), "=&v"(t1[1]), "=&v"(t1[2]), "=&v"(t1[3]), "=&v"(t1[4]), "=&v"(t1[5]), "=&v"(t1[6]), "=&v"(t1[7]) \
                : "v"(va_), "v"((va_) + 16u * ATT_KP) : "memory")
        ATT_VREAD(va, "");
        const int qq = 16 * qi + l15; const bool blk_ok = (kp0 >= 0) && (kp0 < n);
        if (kb != 1) {
            const int c0 = qq - 4 * g;
            if (kb == 0) { const int cth = blk_ok ? c0 : 1000;
#pragma unroll
                for (int kt = 0; kt < 4; ++kt)
#pragma unroll
                    for (int e = 0; e < 4; ++e) sc[kt][e] = (16 * kt + e >= cth) ? sc[kt][e] : -1e30f; }
            else { const int cth = blk_ok ? c0 : -1000;
#pragma unroll
                for (int kt = 0; kt < 4; ++kt)
#pragma unroll
                    for (int e = 0; e < 4; ++e) sc[kt][e] = (16 * kt + e <= cth) ? sc[kt][e] : -1e30f; }
        }
        float mx = fmaxf(fmaxf(sc[0][0], sc[0][1]), fmaxf(sc[0][2], sc[0][3]));
#pragma unroll
        for (int kt = 1; kt < 4; ++kt) mx = fmaxf(mx, fmaxf(fmaxf(sc[kt][0], sc[kt][1]), fmaxf(sc[kt][2], sc[kt][3])));
        mx = fmaxf(mx, __shfl_xor(mx, 16)); mx = fmaxf(mx, __shfl_xor(mx, 32));
        const float mnew = fmaxf(mrow, mx), alpha = __builtin_amdgcn_exp2f(mrow - mnew);
        float rs = 0.f; float p[4][4];
#pragma unroll
        for (int kt = 0; kt < 4; ++kt)
#pragma unroll
            for (int e = 0; e < 4; ++e) { p[kt][e] = __builtin_amdgcn_exp2f(sc[kt][e] - mnew); rs += p[kt][e]; }
        rs += __shfl_xor(rs, 16); rs += __shfl_xor(rs, 32);
        lrow = lrow * alpha + rs; mrow = mnew;
#pragma unroll
        for (int c = 0; c < 8; ++c) Ot[c] = Ot[c] * alpha;
        asm volatile("s_waitcnt lgkmcnt(0)"
            : "+v"(t0[0]), "+v"(t0[1]), "+v"(t0[2]), "+v"(t0[3]), "+v"(t0[4]), "+v"(t0[5]), "+v"(t0[6]), "+v"(t0[7]),
              "+v"(t1[0]), "+v"(t1[1]), "+v"(t1[2]), "+v"(t1[3]), "+v"(t1[4]), "+v"(t1[5]), "+v"(t1[6]), "+v"(t1[7]) :: "memory");
#pragma unroll
        for (int ks = 0; ks < 2; ++ks) {
            union { bf16x8 v; unsigned u[4]; } pf;
            pf.u[0] = pg8::cvt_pk_bf16(p[2 * ks][0], p[2 * ks][1]); pf.u[1] = pg8::cvt_pk_bf16(p[2 * ks][2], p[2 * ks][3]); pf.u[2] = pg8::cvt_pk_bf16(p[2 * ks + 1][0], p[2 * ks + 1][1]); pf.u[3] = pg8::cvt_pk_bf16(p[2 * ks + 1][2], p[2 * ks + 1][3]);
            if (ks == 1) { const unsigned va1 = va + 32u * ATT_KP; ATT_VREAD(va1, "s_waitcnt lgkmcnt(0)"); }
#pragma unroll
            for (int c = 0; c < 8; ++c) { union { bf16x8 v; unsigned u[4]; } vf; vf.u[0] = t0[c].x; vf.u[1] = t0[c].y; vf.u[2] = t1[c].x; vf.u[3] = t1[c].y;
                Ot[c] = __builtin_amdgcn_mfma_f32_16x16x32_bf16(vf.v, pf.v, Ot[c], 0, 0, 0); }
        }
        if (kb == 2) {
            const float il = 1.0f / lrow; const size_t mrowi = (size_t)(b * SEQ + cls + r * pq);
            bf16* op = obr + (size_t)br * T * D + mrowi * D + h * 128 + 4 * g;
#pragma unroll
            for (int c = 0; c < 8; ++c) { v2u wv; wv.x = pg8::cvt_pk_bf16(Ot[c][0] * il, Ot[c][1] * il); wv.y = pg8::cvt_pk_bf16(Ot[c][2] * il, Ot[c][3] * il); *(GAS v2u*)(op + 16 * c) = wv; }
            if (g == 0) lse[(size_t)br * T * NH + mrowi * NH + h] = (mrow + __builtin_amdgcn_logf(lrow)) * 0.6931471805599453f;
        }
        asm volatile("s_waitcnt lgkmcnt(0)" ::: "memory");
        if (lane == 0) aflag[qi] = (unsigned)(it + 1);
        for (;;) { const v4u fl = *(volatile LAS v4u*)aflag; const unsigned mn = min(min(fl.x, fl.y), min(fl.z, fl.w)); if (__builtin_amdgcn_readfirstlane(mn) >= (unsigned)(it + 1)) break; }
        asm volatile("" ::: "memory");
    }
    __builtin_amdgcn_s_setprio(0);
#undef ATT_VREAD
#undef ATT_UNIT
#undef ATT_PREFETCH
}
__device__ __forceinline__ void attn_combine_phase(Frame& F) {
    const int gw = F.vcu * NWAVES + F.wave, NGW = F.G * NWAVES, lane = F.lane;
    for (int m = gw; m < T; m += NGW) {
        float o[4][8]; float amax = 0.f;
#pragma unroll
        for (int pass = 0; pass < 4; ++pass) {
            const int c0 = (pass * 64 + lane) * 8, hh = c0 >> 7;
            const float l0 = ((float*)(F.ws + A_LSE))[(size_t)m * NH + hh], l1 = ((float*)(F.ws + A_LSE))[(size_t)T * NH + (size_t)m * NH + hh], l2 = ((float*)(F.ws + A_LSE))[(size_t)2 * T * NH + (size_t)m * NH + hh];
            const float mx = fmaxf(l0, fmaxf(l1, l2)); const float e0 = __expf(l0 - mx), e1 = __expf(l1 - mx), e2 = __expf(l2 - mx); const float is = 1.0f / (e0 + e1 + e2);
            const float w0 = e0 * is, w1 = e1 * is, w2 = e2 * is;
            const v4u a = *(const GAS v4u*)(((bf16*)(F.ws + A_OF)) + (size_t)m * D + c0), bq = *(const GAS v4u*)(((bf16*)(F.ws + A_OF)) + (size_t)T * D + (size_t)m * D + c0), cq = *(const GAS v4u*)(((bf16*)(F.ws + A_OF)) + (size_t)2 * T * D + (size_t)m * D + c0);
            const unsigned aw[4] = {a.x, a.y, a.z, a.w}, bw[4] = {bq.x, bq.y, bq.z, bq.w}, cw[4] = {cq.x, cq.y, cq.z, cq.w};
#pragma unroll
            for (int j = 0; j < 4; ++j) { o[pass][2 * j] = w0 * bflo(aw[j]) + w1 * bflo(bw[j]) + w2 * bflo(cw[j]); o[pass][2 * j + 1] = w0 * bfhi(aw[j]) + w1 * bfhi(bw[j]) + w2 * bfhi(cw[j]);
                amax = fmaxf(amax, fmaxf(fabsf(o[pass][2 * j]), fabsf(o[pass][2 * j + 1]))); }
        }
#pragma unroll
        for (int x = 1; x < 64; x <<= 1) amax = fmaxf(amax, __shfl_xor(amax, x));
        amax = fmaxf(amax, 1e-20f);
        const float rsv = __builtin_bit_cast(float, (__builtin_bit_cast(unsigned, amax * (1.0f / 127.0f)) + 0xFFFFu) & 0xFFFF0000u);
        const float qs = 1.0f / rsv;
        if (lane == 0) ((float*)(F.ws + A_RSTOK))[m] = rsv;
#pragma unroll
        for (int pass = 0; pass < 4; ++pass) { const int c0 = (pass * 64 + lane) * 8;
            v2u w; w.x = pg8::pk4_i8(o[pass][0] * qs, o[pass][1] * qs, o[pass][2] * qs, o[pass][3] * qs); w.y = pg8::pk4_i8(o[pass][4] * qs, o[pass][5] * qs, o[pass][6] * qs, o[pass][7] * qs);
            *(GAS v2u*)((F.ws + A_OB) + (size_t)m * D + c0) = w; }
    }
}

__device__ __forceinline__ void router_phase(Frame& F) {
    const int tid = F.tid, lane = F.lane, w = F.wave;
    LAS int* sE = (LAS int*)F.lds;
    LAS float* sG = (LAS float*)(F.lds + 512);
    LAS int* lcnt = (LAS int*)(F.lds + 1024);
    LAS int* gbase = (LAS int*)(F.lds + 1088);
    LAS float* LW = (LAS float*)(F.lds + 4096);
    const float* gain = (KARG->in[1]) + 3 * D;
    for (int idx = tid; idx < D * 2; idx += NTHREADS) { const int c = idx >> 1, hf = idx & 1, j = c >> 8, ln = (c & 255) >> 2, q = c & 3;
        *(LAS f32x4*)(LW + ((j * 4 + q) * 64 + ln) * 8 + hf * 4) = *(const GAS f32x4*)((KARG->in[13]) + (size_t)c * NE + hf * 4); }
    __syncthreads();
    for (int blk = blockIdx.x; blk < T / 64; blk += F.G) {
        if (tid < 8) lcnt[tid] = 0;
        f32x4 v[8];
#pragma unroll 1
        for (int i = 0; i < 8; ++i) {
            const int ti = w * 8 + i, m = blk * 64 + ti;
            const GAS f32x4* gr = (const GAS f32x4*)gain + lane;
            { const GAS f32x4* xr = (const GAS f32x4*)((KARG->out) + (size_t)m * D) + lane;
#pragma unroll
              for (int j = 0; j < 8; ++j) v[j] = xr[64 * j]; }
            float s = 0.f, amax = 0.f;
#pragma unroll
            for (int j = 0; j < 8; ++j) { s += (v[j].x * v[j].x + v[j].y * v[j].y) + (v[j].z * v[j].z + v[j].w * v[j].w); const f32x4 g = gr[64 * j]; v[j] = v[j] * g;
                amax = fmaxf(amax, fmaxf(fmaxf(fabsf(v[j].x), fabsf(v[j].y)), fmaxf(fabsf(v[j].z), fabsf(v[j].w)))); }
#pragma unroll
            for (int o = 1; o < 64; o <<= 1) { s += __shfl_xor(s, o); amax = fmaxf(amax, __shfl_xor(amax, o)); }
            const float r = 1.0f / sqrtf(s * (1.f / D) + EPS);
            amax = fmaxf(amax * r, 1e-20f);
            const float rsv = __builtin_bit_cast(float, (__builtin_bit_cast(unsigned, amax * (1.0f / 127.0f)) + 0xFFFFu) & 0xFFFF0000u);
            const float qs = 1.0f / rsv;
            if (lane == 0) ((float*)(F.ws + A_RSTOK))[m] = rsv;
            GAS unsigned* o8 = (GAS unsigned*)((F.ws + A_HN) + (size_t)m * D) + lane;
            float lg[8];
#pragma unroll
            for (int e = 0; e < 8; ++e) lg[e] = 0.f;
#pragma unroll
            for (int j = 0; j < 8; ++j) { const float y[4] = {v[j].x * r, v[j].y * r, v[j].z * r, v[j].w * r};
                o8[64 * j] = pg8::pk4_i8(y[0] * qs, y[1] * qs, y[2] * qs, y[3] * qs);
#pragma unroll
                for (int q = 0; q < 4; ++q) { const LAS f32x4* wp = (const LAS f32x4*)(LW + ((j * 4 + q) * 64 + lane) * 8); const f32x4 wa = wp[0], wb = wp[1];
                    lg[0] = fmaf(y[q], wa.x, lg[0]); lg[1] = fmaf(y[q], wa.y, lg[1]); lg[2] = fmaf(y[q], wa.z, lg[2]); lg[3] = fmaf(y[q], wa.w, lg[3]);
                    lg[4] = fmaf(y[q], wb.x, lg[4]); lg[5] = fmaf(y[q], wb.y, lg[5]); lg[6] = fmaf(y[q], wb.z, lg[6]); lg[7] = fmaf(y[q], wb.w, lg[7]); }
                __builtin_amdgcn_sched_barrier(0); }
            float l4[4], l2[2], l1;
#pragma unroll
            for (int q = 0; q < 4; ++q) { const bool hi = (lane & 32) != 0; const float snd = hi ? lg[q] : lg[q + 4], kp = hi ? lg[q + 4] : lg[q]; l4[q] = kp + __shfl_xor(snd, 32); }
#pragma unroll
            for (int q = 0; q < 2; ++q) { const bool hi = (lane & 16) != 0; const float snd = hi ? l4[q] : l4[q + 2], kp = hi ? l4[q + 2] : l4[q]; l2[q] = kp + __shfl_xor(snd, 16); }
            { const bool hi = (lane & 8) != 0; const float snd = hi ? l2[0] : l2[1], kp = hi ? l2[1] : l2[0]; l1 = kp + __shfl_xor(snd, 8); }
            l1 += __shfl_xor(l1, 4); l1 += __shfl_xor(l1, 2); l1 += __shfl_xor(l1, 1);
#pragma unroll
            for (int e = 0; e < 8; ++e) lg[e] = __shfl(l1, ((e >> 2) & 1) * 32 + ((e >> 1) & 1) * 16 + (e & 1) * 8);
            int e0 = 0; float b0 = lg[0];
#pragma unroll
            for (int e = 1; e < 8; ++e) if (lg[e] > b0) { b0 = lg[e]; e0 = e; }
            int e1 = -1; float b1 = -3.0e38f;
#pragma unroll
            for (int e = 0; e < 8; ++e) if (e != e0 && lg[e] > b1) { b1 = lg[e]; e1 = e; }
            const float g1 = 1.0f / (1.0f + __expf(b0 - b1)), g0 = 1.0f - g1;
            if (lane == 0) { sE[2 * ti] = e0; sE[2 * ti + 1] = e1; sG[2 * ti] = g0; sG[2 * ti + 1] = g1; }
        }
        __syncthreads();
        int e0 = 0, e1 = 0, r0 = 0, r1 = 0;
        if (tid < 64) { e0 = sE[2 * tid]; e1 = sE[2 * tid + 1]; r0 = atomicAdd((int*)&lcnt[e0], 1); r1 = atomicAdd((int*)&lcnt[e1], 1); }
        __syncthreads();
        if (tid < 8) gbase[tid] = (int)__hip_atomic_fetch_add(F.ctl + CW_MOE + 64 * tid, (unsigned)lcnt[tid], RLX_AGENT);
        __syncthreads();
        if (tid < 64) { const int m = blk * 64 + tid; int* rc = ((int*)(F.ws + A_REC)) + (size_t)m * 8;
            rc[0] = e0; rc[1] = gbase[e0] + r0; rc[2] = e1; rc[3] = gbase[e1] + r1; rc[4] = __builtin_bit_cast(int, sG[2 * tid]); rc[5] = __builtin_bit_cast(int, sG[2 * tid + 1]);
            sE[2 * tid] = e0 * T + gbase[e0] + r0; sE[2 * tid + 1] = e1 * T + gbase[e1] + r1; }
        asm volatile("s_waitcnt vmcnt(0)" ::: "memory");
        __syncthreads();
#pragma unroll 2
        for (int i = 0; i < 8; ++i) { const int ti = w * 8 + i, m = blk * 64 + ti; const int s0 = sE[2 * ti], s1 = sE[2 * ti + 1];
            const GAS v4u* src = (const GAS v4u*)((F.ws + A_HN) + (size_t)m * D) + lane;
            GAS v4u* d0 = (GAS v4u*)((F.ws + A_XG) + (size_t)s0 * D) + lane; GAS v4u* d1 = (GAS v4u*)((F.ws + A_XG) + (size_t)s1 * D) + lane;
            const v4u va = src[0], vb = src[64]; d0[0] = va; d0[64] = vb; d1[0] = va; d1[64] = vb;
            if (lane == 0) { const float rs = ((float*)(F.ws + A_RSTOK))[m]; ((float*)(F.ws + A_RSSLOT))[s0] = rs; ((float*)(F.ws + A_RSSLOT))[s1] = rs; } }
        __syncthreads();
    }
}
__device__ __forceinline__ void moe_tiles(Frame& F, int (&cnt)[8], int (&ct)[9]) {
    ct[0] = 0;
#pragma unroll
    for (int e = 0; e < 8; ++e) { cnt[e] = __builtin_amdgcn_readfirstlane((int)__hip_atomic_load(F.ctl + CW_MOE + 64 * e, RLX_AGENT)); ct[e + 1] = ct[e] + ((cnt[e] + 255) >> 8); }
}
__device__ __forceinline__ int moe_full_tiles(int ntiles) { return (ntiles / 32) * 32; }
template <int PART> __device__ __forceinline__ void moe_combine_phase(Frame& F) {
    const int lane = F.lane;
    const bf16* y = ((bf16*)(F.ws + A_XG));
    int cnt[8], ct[9]; moe_tiles(F, cnt, ct);
    const int ntA = moe_full_tiles(ct[8]), ntu = (ct[8] - ntA) * (D / 256), ntw = ntu < F.G ? ntu : F.G, nfree = F.G - ntw;
    const int gw = (PART == 1 ? ((int)blockIdx.x - ntw) : F.vcu) * NWAVES + F.wave, NGW = (PART == 1 ? nfree : F.G) * NWAVES;
    if (PART == 1 && (int)blockIdx.x < ntw) return;
    for (int m = gw; m < T; m += NGW) {
        const int* rc = ((int*)(F.ws + A_REC)) + (size_t)m * 8; const int e0 = rc[0], r0 = rc[1], e1 = rc[2], r1 = rc[3];
        int o0 = 0, o1 = 0;
#pragma unroll
        for (int e = 0; e < 8; ++e) { if (e == e0) o0 = ct[e]; if (e == e1) o1 = ct[e]; }
        const bool late = (o0 + (r0 >> 8) >= ntA) || (o1 + (r1 >> 8) >= ntA);
        if (PART == 1 ? late : (!late && nfree > 0)) continue;
        const int s0 = o0 * 256 + r0, s1 = o1 * 256 + r1;
        const float g0 = __builtin_bit_cast(float, ((int*)(F.ws + A_REC))[(size_t)m * 8 + 4]), g1 = __builtin_bit_cast(float, ((int*)(F.ws + A_REC))[(size_t)m * 8 + 5]);
        v4u a4[4], b4[4]; f32x4 xa[4], xb[4];
#pragma unroll
        for (int pass = 0; pass < 4; ++pass) { const int c0 = (pass * 64 + lane) * 8;
            a4[pass] = *(const GAS v4u*)(y + (size_t)s0 * D + c0); b4[pass] = *(const GAS v4u*)(y + (size_t)s1 * D + c0);
            const float* ip = (KARG->out) + (size_t)m * D + c0; xa[pass] = *(const GAS f32x4*)ip; xb[pass] = *(const GAS f32x4*)(ip + 4); }
#pragma unroll
        for (int pass = 0; pass < 4; ++pass) {
            const int c0 = (pass * 64 + lane) * 8;
            const v4u a = a4[pass], bq = b4[pass];
            float* op = (KARG->out) + (size_t)m * D + c0; f32x4 x0 = xa[pass], x1 = xb[pass];
            x0.x += g0 * bflo(a.x) + g1 * bflo(bq.x); x0.y += g0 * bfhi(a.x) + g1 * bfhi(bq.x); x0.z += g0 * bflo(a.y) + g1 * bflo(bq.y); x0.w += g0 * bfhi(a.y) + g1 * bfhi(bq.y);
            x1.x += g0 * bflo(a.z) + g1 * bflo(bq.z); x1.y += g0 * bfhi(a.z) + g1 * bfhi(bq.z); x1.z += g0 * bflo(a.w) + g1 * bflo(bq.w); x1.w += g0 * bfhi(a.w) + g1 * bfhi(bq.w);
            *(GAS f32x4*)op = x0; *(GAS f32x4*)(op + 4) = x1;
        }
    }
}

#ifndef MK_PER_PHASE
#define MK_PER_PHASE 0
#endif
__global__ void __launch_bounds__(NTHREADS, 2) mk_fwd(Args args) {
    extern __shared__ __attribute__((aligned(16))) unsigned char lds[];
    Frame F;
    F.lds = (LAS unsigned char*)lds;
    F.tid = threadIdx.x; F.lane = F.tid & 63; F.wave = __builtin_amdgcn_readfirstlane(F.tid >> 6);
    F.G = gridDim.x; { const int bx = blockIdx.x; F.vcu = (F.G % 8 == 0) ? (bx % 8) * (F.G / 8) + bx / 8 : bx; }
    F.ws = args.ws; F.ctl = (unsigned*)(args.ws + WS_CTL);
    volatile LAS unsigned* MISC = (volatile LAS unsigned*)(F.lds + MISC_OFF);
    if (F.tid < 32) MISC[F.tid] = 0u;
    __syncthreads();
    const int lo = args.ph_lo, hi = args.ph_hi;
    XcdBarrier bar; bar.bar = F.ctl + CW_BAR; bar.x = 0; bar.st = nullptr;
    if (hi - lo > 1) bar = xcd_barrier_post(F.ctl + CW_BAR, MISC + 8);
#define IN(k) (lo <= (k) && (k) < hi)
#ifndef MK_AMP_MASK
#define MK_AMP_MASK 0u
#endif
    unsigned long long amp_t0 = MK_AMP_MASK ? __builtin_amdgcn_s_memrealtime() : 0ull;
#define SEAM(k) do { if (IN(k) && IN((k) + 1)) xcd_barrier(bar, F.wave == 0 && lane_id() == 0); REFRESH(F); \
        if (MK_AMP_MASK) { const unsigned long long t1_ = __builtin_amdgcn_s_memrealtime(); \
            if ((MK_AMP_MASK >> (k)) & 1u) { const unsigned long long d_ = t1_ - amp_t0; while (__builtin_amdgcn_s_memrealtime() - t1_ < d_) __builtin_amdgcn_s_sleep(8); } \
            amp_t0 = __builtin_amdgcn_s_memrealtime(); } } while (0)
    typedef pg8::StaticOrder SO;

    if (IN(0)) { p0_prologue(F); } SEAM(0);
    if (IN(1)) { pg8::Gemm g{((bf16*)(F.ws + A_HN)), ((bf16*)(F.ws + WS_W_IN)), D / 2}; SO S; S.init(T / 256, N_IN / 256, F.G, (int)blockIdx.x);
        pg8::EpiBf16 E{((bf16*)(F.ws + A_BIG)), N_IN, 1.0f / Q_W2048, (const float*)(F.ws + A_RSTOK), 1};
        pg8::gemm_phase<pg8::EpiBf16, SO, true, true, 2>(F.lds, g, S, E, F.tid); } SEAM(1);
    if (IN(2)) { scan_phase(F); } SEAM(2);
    if (IN(3)) { onorm_phase(F); } SEAM(3);
    if (IN(4)) { pg8::Gemm g{((bf16*)(F.ws + A_OB)), ((bf16*)(F.ws + WS_W_HO)), D}; SO S; S.init(T / 256, D / 256, F.G, (int)blockIdx.x); pg8::EpiResF32 E{(KARG->in[0]), (KARG->out), D, 1.0f, nullptr};
        pg8::gemm_phase<pg8::EpiResF32, SO, true, true>(F.lds, g, S, E, F.tid); } SEAM(4);
    if (IN(5)) { rms_phase_q8(F, (KARG->out), (KARG->in[1]) + D); } SEAM(5);
    if (IN(6)) { pg8::Gemm g{((bf16*)(F.ws + A_HN)), ((bf16*)(F.ws + WS_W_GU)), D / 2}; SO S; S.init(T / 256, NGU / 256, F.G, (int)blockIdx.x);
        pg8::EpiSwigluQ8 E{(F.ws + A_BIG), FFNP, 1.0f / Q_W2048, Q_HID, (float*)(F.ws + A_RSTOK)};
        pg8::gemm_phase<pg8::EpiSwigluQ8, SO, true, true, 2>(F.lds, g, S, E, F.tid); } SEAM(6);
    if (IN(7)) { pg8::Gemm g{((bf16*)(F.ws + A_BIG)), ((bf16*)(F.ws + WS_W_DN)), FFNP / 2}; SO S; S.init(T / 256, D / 256, F.G, (int)blockIdx.x);
        pg8::EpiResF32 E{(KARG->out), (KARG->out), D, 1.0f / (Q_HID * Q_W5504), nullptr};
        pg8::gemm_phase<pg8::EpiResF32, SO, true, true, 2>(F.lds, g, S, E, F.tid); } SEAM(7);
    if (IN(8)) { rms_phase_q8(F, (KARG->out), (KARG->in[1]) + 2 * D); } SEAM(8);
    if (IN(9)) { pg8::Gemm g{((bf16*)(F.ws + A_HN)), ((bf16*)(F.ws + WS_W_QKV)), D / 2}; SO S; S.init(T / 256, NQKV / 256, F.G, (int)blockIdx.x);
        pg8::EpiBf16 E{((bf16*)(F.ws + A_BIG)), NQKV, 1.0f / Q_W2048, (const float*)(F.ws + A_RSTOK), 0};
        pg8::gemm_phase<pg8::EpiBf16, SO, true, true, 2>(F.lds, g, S, E, F.tid); } SEAM(9);
    if (IN(10)) { qknorm_rope_phase(F); } SEAM(10);
    if (IN(11)) { attn_phase(F); } SEAM(11);
    if (IN(12)) { attn_combine_phase(F); } SEAM(12);
    if (IN(13)) { pg8::Gemm g{((bf16*)(F.ws + A_OB)), ((bf16*)(F.ws + WS_W_AO)), D / 2}; SO S; S.init(T / 256, D / 256, F.G, (int)blockIdx.x);
        pg8::EpiResF32 E{(KARG->out), (KARG->out), D, 1.0f / Q_W2048, (const float*)(F.ws + A_RSTOK)};
        pg8::gemm_phase<pg8::EpiResF32, SO, true, true, 2>(F.lds, g, S, E, F.tid); } SEAM(13);
    if (IN(14)) { router_phase(F); } SEAM(14);
    if (IN(15)) { int cnt[8], ct[9]; moe_tiles(F, cnt, ct);
        pg8::Gemm g{((bf16*)(F.ws + A_XG)), (const bf16*)(F.ws + WS_W_MGU), D / 2}; pg8::MoeOrder S; S.init(ct[8], NMGU / 256, F.G, (int)blockIdx.x);
        S.c1 = ct[1]; S.c2 = ct[2]; S.c3 = ct[3]; S.c4 = ct[4]; S.c5 = ct[5]; S.c6 = ct[6]; S.c7 = ct[7]; S.estride = (size_t)NMGU * D; S.avirt = T;
        pg8::EpiSwigluQ8 E{(F.ws + A_MH), FE, 1.0f / Q_W2048, Q_HID, ((float*)(F.ws + A_RSSLOT))};
        pg8::gemm_phase<pg8::EpiSwigluQ8, pg8::MoeOrder, true, true, 2>(F.lds, g, S, E, F.tid); } SEAM(15);
    if (IN(16)) { int cnt[8], ct[9]; moe_tiles(F, cnt, ct);
        pg8::Gemm g{(const bf16*)(F.ws + A_MH), (const bf16*)(F.ws + WS_W_MDN), FE / 2}; pg8::MoeOrder S; S.init(moe_full_tiles(ct[8]), D / 256, F.G, (int)blockIdx.x);
        S.c1 = ct[1]; S.c2 = ct[2]; S.c3 = ct[3]; S.c4 = ct[4]; S.c5 = ct[5]; S.c6 = ct[6]; S.c7 = ct[7]; S.estride = (size_t)D * FE; S.avirt = 0;
        pg8::EpiBf16 E{((bf16*)(F.ws + A_XG)), D, 1.0f / (Q_HID * Q_W7168), nullptr, 0};
        pg8::gemm_phase<pg8::EpiBf16, pg8::MoeOrder, true, true, 2>(F.lds, g, S, E, F.tid); } SEAM(16);
    if (IN(17)) { int cnt[8], ct[9]; moe_tiles(F, cnt, ct);
        const int ntA = moe_full_tiles(ct[8]), ntu = (ct[8] - ntA) * (D / 256);
        if ((int)blockIdx.x < ntu) {
            pg8::Gemm g{(const bf16*)(F.ws + A_MH), (const bf16*)(F.ws + WS_W_MDN), FE / 2}; pg8::MoeTailOrder S; S.init(ct[8], D / 256, F.G, (int)blockIdx.x); S.pm0 = ntA; S.ntu = ntu;
            S.c1 = ct[1]; S.c2 = ct[2]; S.c3 = ct[3]; S.c4 = ct[4]; S.c5 = ct[5]; S.c6 = ct[6]; S.c7 = ct[7]; S.estride = (size_t)D * FE; S.avirt = 0;
            pg8::EpiBf16 E{((bf16*)(F.ws + A_XG)), D, 1.0f / (Q_HID * Q_W7168), nullptr, 0};
            pg8::gemm_phase<pg8::EpiBf16, pg8::MoeTailOrder, true, true, 2>(F.lds, g, S, E, F.tid);
        } else moe_combine_phase<1>(F); } SEAM(17);
    if (IN(18)) { moe_combine_phase<2>(F); }
    if (MK_AMP_MASK & (1u << 18)) { asm volatile("s_waitcnt vmcnt(0)" ::: "memory"); const unsigned long long t1_ = __builtin_amdgcn_s_memrealtime(), d_ = t1_ - amp_t0; while (__builtin_amdgcn_s_memrealtime() - t1_ < d_) __builtin_amdgcn_s_sleep(8); }
#undef IN
#undef SEAM
}

extern "C" void kernel_launch(void* const* d_in, const int* in_sizes, int n_in, void* d_out, int out_size, void* d_ws, size_t ws_size, hipStream_t stream) {
    static int grid = 0;
    if (grid == 0) {
        if (n_in != 17 || out_size != T * D || ws_size < WS_END2) { fprintf(stderr, "kernel_launch: unexpected shapes (n_in %d out %d ws %zu need %zu)\n", n_in, out_size, ws_size, (size_t)WS_END2); grid = -1; return; }
        int dev = 0, cus = 0, per_cu = 0;
        if (hipGetDevice(&dev) != hipSuccess || hipDeviceGetAttribute(&cus, hipDeviceAttributeMultiprocessorCount, dev) != hipSuccess) { grid = -1; return; }
        if (hipFuncSetAttribute((const void*)mk_fwd, hipFuncAttributeMaxDynamicSharedMemorySize, LDS_BYTES) != hipSuccess) { fprintf(stderr, "kernel_launch: hipFuncSetAttribute failed\n"); grid = -1; return; }
        if (hipOccupancyMaxActiveBlocksPerMultiprocessor(&per_cu, (const void*)mk_fwd, NTHREADS, LDS_BYTES) != hipSuccess || per_cu < 1) { fprintf(stderr, "kernel_launch: occupancy query reports %d\n", per_cu); }
        (void)hipGetLastError();
        grid = cus;
    }
    if (grid < 0) return;
    (void)hipMemsetAsync((char*)d_ws + WS_CTL, 0, CTL_ZERO_BYTES, stream);
    Args a{};
    for (int i = 0; i < 17; ++i) a.in[i] = (const float*)d_in[i];
    a.out = (float*)d_out; a.ws = (unsigned char*)d_ws;
#if MK_PER_PHASE
    for (int p = 0; p < N_PHASES; ++p) { a.ph_lo = p; a.ph_hi = p + 1; hipLaunchKernelGGL(mk_fwd, dim3(grid), dim3(NTHREADS), LDS_BYTES, stream, a); }
#else
    a.ph_lo = 0; a.ph_hi = N_PHASES;
    hipLaunchKernelGGL(mk_fwd, dim3(grid), dim3(NTHREADS), LDS_BYTES, stream, a);
#endif
}
```

```cpp
#include <hip/hip_runtime.h>
#include <cstdio>
#include <cstdint>

namespace pg8 {
#define PG8_LAS __attribute__((address_space(3)))
typedef unsigned short bf16_t;
typedef short bf16x8 __attribute__((ext_vector_type(8)));
typedef float f32x4 __attribute__((ext_vector_type(4)));
typedef unsigned u32x4 __attribute__((ext_vector_type(4)));
constexpr int BM = 256, BK = 64, HALF = 128, HTB = HALF * BK * 2  , STAGE_BYTES = 8 * HTB, NXCD = 8, WGM = 8;

__host__ __device__ __forceinline__ int lds_byte(int r, int c) { const int st = (r >> 4) * 2 + (c >> 5), rr = r & 15, cc = c & 31, ob = rr * 64 + cc * 2; return st * 1024 + (ob ^ (((ob >> 9) & 1) << 5)); }
__host__ __device__ __forceinline__ void stage_rc(int b, int& R, int& C) { const int st = b / 1024, sb = b % 1024, swz = sb ^ (((sb >> 9) & 1) << 5); R = (st >> 1) * 16 + swz / 64; C = (st & 1) * 32 + (swz % 64) / 2; }
__host__ __device__ __forceinline__ int perm32(int rho) { const int n = rho >> 4, i = rho & 15; return 8 * (i >> 2) + 4 * n + (i & 3); }

struct Unit { int pm, pn, ui, ar; };
constexpr int RS_CAP = 30, RS_LDS_OFF = 131072;
struct Gemm { const bf16_t* A; const bf16_t* Bt; int K; };

struct StaticOrder {
    int nM, nN, nwg, G, c;
    __host__ __device__ void init(int nM_, int nN_, int G_, int c_) { nM = nM_; nN = nN_; nwg = nM * nN; G = G_; c = c_; }
    __host__ __device__ bool next(int i, Unit& u) const {
        const long L = (long)i * G + c; if (L >= nwg) return false;
        int wgid = (int)L; { const int q = nwg / NXCD, r = nwg % NXCD, xcd = wgid % NXCD, off = wgid / NXCD; wgid = (xcd < r ? xcd * (q + 1) : r * (q + 1) + (xcd - r) * q) + off; }
        const int nig = WGM * nN, gid = wgid / nig, fm = gid * WGM, gsz = (nM - fm) < WGM ? (nM - fm) : WGM;
        u.pm = fm + ((wgid % nig) % gsz); u.pn = (wgid % nig) / gsz; return true;
    }
    __device__ __forceinline__ const char* a_ptr(const Gemm& g, const Unit& u, size_t tstep) const { return (const char*)g.A + (size_t)u.pm * tstep; }
    __device__ __forceinline__ int arow0(const Unit& u) const { return u.pm * BM; }
    __device__ __forceinline__ const char* b_ptr(const Gemm& g, const Unit& u, size_t tstep) const { return (const char*)g.Bt + (size_t)u.pn * tstep; }
    __device__ __forceinline__ void a_ready(const Unit&) const {}
    __device__ __forceinline__ void done(const Unit&) const {}
};
struct MoeOrder : StaticOrder {
    int c1, c2, c3, c4, c5, c6, c7; size_t estride; int avirt;
    __device__ __forceinline__ int tile0(int pm) const { int t = 0; t = pm >= c1 ? c1 : t; t = pm >= c2 ? c2 : t; t = pm >= c3 ? c3 : t; t = pm >= c4 ? c4 : t; t = pm >= c5 ? c5 : t; t = pm >= c6 ? c6 : t; t = pm >= c7 ? c7 : t; return t; }
    __device__ __forceinline__ int arow0(const Unit& u) const { return avirt ? __builtin_amdgcn_readfirstlane(expert(u.pm) * avirt + (u.pm - tile0(u.pm)) * BM) : u.pm * BM; }
    __device__ __forceinline__ const char* a_ptr(const Gemm& g, const Unit& u, size_t tstep) const { return (const char*)g.A + (size_t)arow0(u) * (tstep / BM); }
    __device__ __forceinline__ int expert(int pm) const { return (pm >= c1) + (pm >= c2) + (pm >= c3) + (pm >= c4) + (pm >= c5) + (pm >= c6) + (pm >= c7); }
    __device__ __forceinline__ const char* b_ptr(const Gemm& g, const Unit& u, size_t tstep) const { return (const char*)g.Bt + (size_t)__builtin_amdgcn_readfirstlane(expert(u.pm)) * estride + (size_t)u.pn * tstep; }
};
struct MoeTailOrder : MoeOrder {
    int pm0, ntu;
    __device__ __forceinline__ bool next(int i, Unit& u) const { const long L = (long)i * G + c; if (L >= ntu) return false; u.pm = pm0 + (int)L / nN; u.pn = (int)L % nN; return true; }
};

__device__ __forceinline__ unsigned cvt_pk_bf16(float lo, float hi) { unsigned r; asm volatile("v_cvt_pk_bf16_f32 %0, %1, %2" : "=v"(r) : "v"(lo), "v"(hi)); return r; }
__device__ __forceinline__ float silu_f(float x) { return x * __builtin_amdgcn_rcpf(1.0f + __expf(-x)); }
typedef int v8i __attribute__((ext_vector_type(8))); typedef int v4i __attribute__((ext_vector_type(4)));
__device__ __forceinline__ v8i cat8(bf16x8 a, bf16x8 b) { return __builtin_shufflevector(__builtin_bit_cast(v4i, a), __builtin_bit_cast(v4i, b), 0, 1, 2, 3, 4, 5, 6, 7); }
#ifndef PK8_BIAS
#define PK8_BIAS 128.0f
#endif
__device__ __forceinline__ unsigned pk4_i8(float a, float b, float c, float d) {
    unsigned r = __builtin_amdgcn_cvt_pk_u8_f32(a + PK8_BIAS, 0u, 0u);
    r = __builtin_amdgcn_cvt_pk_u8_f32(b + PK8_BIAS, 1u, r); r = __builtin_amdgcn_cvt_pk_u8_f32(c + PK8_BIAS, 2u, r); r = __builtin_amdgcn_cvt_pk_u8_f32(d + PK8_BIAS, 3u, r);
    return r ^ 0x80808080u; }
__device__ __forceinline__ float clamp448(float x) { return fminf(fmaxf(x, -448.f), 448.f); }
__device__ __forceinline__ unsigned pk4_fp8(float a, float b, float c, float d) { int w = 0; w = __builtin_amdgcn_cvt_pk_fp8_f32(clamp448(a), clamp448(b), w, false); w = __builtin_amdgcn_cvt_pk_fp8_f32(clamp448(c), clamp448(d), w, true); return (unsigned)w; }

__device__ __forceinline__ float row_scale(const float* rowscale, const Unit& u, int rloc  , PG8_LAS unsigned char* lds) {
    if (u.ui < RS_CAP) return __builtin_bit_cast(float, (unsigned)(*(const PG8_LAS unsigned short*)(lds + RS_LDS_OFF + (u.ui * 256 + rloc) * 2)) << 16);
    float x; const __attribute__((address_space(1))) float* p = (const __attribute__((address_space(1))) float*)rowscale + (u.ar + rloc);
    asm volatile("global_load_dword %0, %1, off\n\ts_waitcnt vmcnt(0)" : "=&v"(x) : "v"(p) : "memory");
    return x;
}
struct EpiBf16 {
    static constexpr bool PERM = true, AFTER_DRAIN = false;
    bf16_t* O; int ldc; float sc; const float* rowscale; int hgrn_act;
    __device__ __forceinline__ void operator()(const f32x4 (&acc)[2][2][4][2], const Unit& u, int wr, int wc, int fr, int fq, PG8_LAS unsigned char* lds) const {
        const int row0 = u.pm * BM + wr * 64 + fr, col0 = u.pn * BM + wc * 32 + 8 * fq;
#pragma unroll
        for (int ai = 0; ai < 2; ++ai)
#pragma unroll
            for (int m = 0; m < 4; ++m) { bf16_t* rowp = O + (size_t)(row0 + ai * HALF + m * 16) * ldc + col0;
                const float s = rowscale ? sc * row_scale(rowscale, u, wr * 64 + fr + ai * HALF + m * 16, lds) : sc;
#pragma unroll
                for (int bj = 0; bj < 2; ++bj) { f32x4 v0 = acc[ai][bj][m][0] * s, v1 = acc[ai][bj][m][1] * s;
                    if (hgrn_act) { const int sec = (u.pn * BM) >> 11;
                        if (sec <= 2) {
#pragma unroll
                            for (int j = 0; j < 4; ++j) { const float s0 = __builtin_amdgcn_rcpf(1.0f + __expf(-v0[j])), s1 = __builtin_amdgcn_rcpf(1.0f + __expf(-v1[j])); v0[j] = sec == 0 ? v0[j] * s0 : s0; v1[j] = sec == 0 ? v1[j] * s1 : s1; } } }
                    u32x4 w; w.x = cvt_pk_bf16(v0[0], v0[1]); w.y = cvt_pk_bf16(v0[2], v0[3]); w.z = cvt_pk_bf16(v1[0], v1[1]); w.w = cvt_pk_bf16(v1[2], v1[3]);
                    *(u32x4*)(rowp + bj * HALF) = w; } }
    }
};
constexpr int QR_X_OFF = RS_LDS_OFF + 4096, QR_G_OFF = RS_LDS_OFF + 12288;
struct EpiQkvRope {
    static constexpr bool PERM = true, AFTER_DRAIN = false;
    bf16_t* O; int ldc; float sc; const float* rowscale; float eps, qscale; int posmask;
    __device__ __forceinline__ void operator()(const f32x4 (&acc)[2][2][4][2], const Unit& u, int wr, int wc, int fr, int fq, PG8_LAS unsigned char* lds) const {
        const int row0 = u.pm * BM + wr * 64 + fr, col0 = u.pn * BM + wc * 32 + 8 * fq;
        if (u.pn >= 16) {
#pragma unroll
            for (int ai = 0; ai < 2; ++ai)
#pragma unroll
                for (int m = 0; m < 4; ++m) { bf16_t* rowp = O + (size_t)(row0 + ai * HALF + m * 16) * ldc + col0;
                    const float s = sc * row_scale(rowscale, u, wr * 64 + fr + ai * HALF + m * 16, lds);
#pragma unroll
                    for (int bj = 0; bj < 2; ++bj) { const f32x4 v0 = acc[ai][bj][m][0] * s, v1 = acc[ai][bj][m][1] * s;
                        u32x4 w; w.x = cvt_pk_bf16(v0[0], v0[1]); w.y = cvt_pk_bf16(v0[2], v0[3]); w.z = cvt_pk_bf16(v1[0], v1[1]); w.w = cvt_pk_bf16(v1[2], v1[3]);
                        *(u32x4*)(rowp + bj * HALF) = w; } }
            return;
        }
        const bool isq = u.pn < 8;
        PG8_LAS float* X = (PG8_LAS float*)(lds + QR_X_OFF);
#pragma unroll
        for (int ai = 0; ai < 2; ++ai)
#pragma unroll
            for (int m = 0; m < 4; ++m) { const int rloc = wr * 64 + fr + ai * HALF + m * 16; const float s = sc * row_scale(rowscale, u, rloc, lds);
#pragma unroll
                for (int bj = 0; bj < 2; ++bj) { const f32x4 v0 = acc[ai][bj][m][0] * s, v1 = acc[ai][bj][m][1] * s;
                    float t = ((v0[0] * v0[0] + v0[1] * v0[1]) + (v0[2] * v0[2] + v0[3] * v0[3])) + ((v1[0] * v1[0] + v1[1] * v1[1]) + (v1[2] * v1[2] + v1[3] * v1[3]));
                    t += __shfl_xor(t, 16); t += __shfl_xor(t, 32);
                    if (fq == 0) X[(rloc * 2 + bj) * 4 + wc] = t; } }
        asm volatile("s_waitcnt lgkmcnt(0)" ::: "memory"); __builtin_amdgcn_s_barrier(); asm volatile("" ::: "memory");
        float inv[4], g1[4], g2[4];
        const PG8_LAS float* G = (const PG8_LAS float*)(lds + QR_G_OFF) + (isq ? 0 : 128);
#pragma unroll
        for (int j = 0; j < 4; ++j) { const int i = 16 * wc + 4 * fq + j; inv[j] = expf(-(float)i * (2.0f / 128.0f) * 9.210340371976184f) * 0.15915494309189535f; g1[j] = G[i]; g2[j] = G[64 + i]; }
        const float qs = isq ? qscale : 1.0f;
#pragma unroll
        for (int ai = 0; ai < 2; ++ai)
#pragma unroll
            for (int m = 0; m < 4; ++m) { const int rloc = wr * 64 + fr + ai * HALF + m * 16, row = u.pm * BM + rloc; const float s = sc * row_scale(rowscale, u, rloc, lds);
                const float pos = (float)(row & posmask);
                float sn[4], cs[4];
#pragma unroll
                for (int j = 0; j < 4; ++j) { float rev = pos * inv[j]; rev -= floorf(rev); sn[j] = __builtin_amdgcn_sinf(rev); cs[j] = __builtin_amdgcn_cosf(rev); }
                bf16_t* rowp = O + (size_t)row * ldc + col0;
#pragma unroll
                for (int bj = 0; bj < 2; ++bj) { const f32x4 part = *(const PG8_LAS f32x4*)(X + (rloc * 2 + bj) * 4);
                    const float tot = (part[0] + part[1]) + (part[2] + part[3]);
                    const float r = (1.0f / sqrtf(tot * (1.f / 128.f) + eps)) * qs * s;
                    const f32x4 a0 = acc[ai][bj][m][0], a1 = acc[ai][bj][m][1];
                    float o1[4], o2[4];
#pragma unroll
                    for (int j = 0; j < 4; ++j) { const float y1 = a0[j] * r * g1[j], y2 = a1[j] * r * g2[j]; o1[j] = y1 * cs[j] - y2 * sn[j]; o2[j] = y2 * cs[j] + y1 * sn[j]; }
                    u32x4 w; w.x = cvt_pk_bf16(o1[0], o1[1]); w.y = cvt_pk_bf16(o1[2], o1[3]); w.z = cvt_pk_bf16(o2[0], o2[1]); w.w = cvt_pk_bf16(o2[2], o2[3]);
                    *(u32x4*)(rowp + bj * HALF) = w; } }
    }
};
struct EpiSwiglu {
    static constexpr bool PERM = true, AFTER_DRAIN = false;
    bf16_t* O; int ldc; float si; const float* rowscale;
    __device__ __forceinline__ void operator()(const f32x4 (&acc)[2][2][4][2], const Unit& u, int wr, int wc, int fr, int fq, PG8_LAS unsigned char* lds) const {
        const int row0 = u.pm * BM + wr * 64 + fr, col0 = u.pn * HALF + wc * 32 + 8 * fq;
#pragma unroll
        for (int ai = 0; ai < 2; ++ai)
#pragma unroll
            for (int m = 0; m < 4; ++m) { bf16_t* rowp = O + (size_t)(row0 + ai * HALF + m * 16) * ldc + col0;
                const float s = rowscale ? si * row_scale(rowscale, u, wr * 64 + fr + ai * HALF + m * 16, lds) : si;
                const f32x4 g0 = acc[ai][0][m][0] * s, g1 = acc[ai][0][m][1] * s, u0 = acc[ai][1][m][0] * s, u1 = acc[ai][1][m][1] * s;
                float h[8];
#pragma unroll
                for (int j = 0; j < 4; ++j) { h[j] = silu_f(g0[j]) * u0[j]; h[4 + j] = silu_f(g1[j]) * u1[j]; }
                u32x4 w; w.x = cvt_pk_bf16(h[0], h[1]); w.y = cvt_pk_bf16(h[2], h[3]); w.z = cvt_pk_bf16(h[4], h[5]); w.w = cvt_pk_bf16(h[6], h[7]);
                *(u32x4*)rowp = w; }
    }
};
struct EpiSwigluF8 {
    static constexpr bool PERM = true, AFTER_DRAIN = false;
    unsigned char* O; int ldc; float si, so;
    __device__ __forceinline__ void operator()(const f32x4 (&acc)[2][2][4][2], const Unit& u, int wr, int wc, int fr, int fq, PG8_LAS unsigned char* lds) const {
        const int row0 = u.pm * BM + wr * 64 + fr, col0 = u.pn * HALF + wc * 32 + 8 * fq;
#pragma unroll
        for (int ai = 0; ai < 2; ++ai)
#pragma unroll
            for (int m = 0; m < 4; ++m) { unsigned char* rowp = O + (size_t)(row0 + ai * HALF + m * 16) * ldc + col0;
                const f32x4 g0 = acc[ai][0][m][0] * si, g1 = acc[ai][0][m][1] * si, u0 = acc[ai][1][m][0] * (si * so), u1 = acc[ai][1][m][1] * (si * so);
                float h[8];
#pragma unroll
                for (int j = 0; j < 4; ++j) { h[j] = silu_f(g0[j]) * u0[j]; h[4 + j] = silu_f(g1[j]) * u1[j]; }
                typedef unsigned u32x2 __attribute__((ext_vector_type(2)));
                u32x2 w; w.x = pk4_fp8(h[0], h[1], h[2], h[3]); w.y = pk4_fp8(h[4], h[5], h[6], h[7]);
                *(u32x2*)rowp = w; }
    }
};
struct EpiSwigluQ8 {
    static constexpr bool PERM = true, AFTER_DRAIN = false;
    unsigned char* O; int ldc; float si, so; const float* rowscale;
    __device__ __forceinline__ void operator()(const f32x4 (&acc)[2][2][4][2], const Unit& u, int wr, int wc, int fr, int fq, PG8_LAS unsigned char* lds) const {
        const int row0 = u.pm * BM + wr * 64 + fr, col0 = u.pn * HALF + wc * 32 + 8 * fq;
#pragma unroll
        for (int ai = 0; ai < 2; ++ai)
#pragma unroll
            for (int m = 0; m < 4; ++m) { const int row = row0 + ai * HALF + m * 16; unsigned char* rowp = O + (size_t)row * ldc + col0;
                const float s = si * row_scale(rowscale, u, wr * 64 + fr + ai * HALF + m * 16, lds);
                const f32x4 g0 = acc[ai][0][m][0] * s, g1 = acc[ai][0][m][1] * s, u0 = acc[ai][1][m][0] * (s * so), u1 = acc[ai][1][m][1] * (s * so);
                float h[8];
#pragma unroll
                for (int j = 0; j < 4; ++j) { h[j] = silu_f(g0[j]) * u0[j]; h[4 + j] = silu_f(g1[j]) * u1[j]; }
                typedef unsigned u32x2 __attribute__((ext_vector_type(2)));
                u32x2 w; w.x = pk4_i8(h[0], h[1], h[2], h[3]); w.y = pk4_i8(h[4], h[5], h[6], h[7]);
                *(u32x2*)rowp = w; }
    }
};
template <bool BASE_F32> struct EpiResB {
    static constexpr bool PERM = true, AFTER_DRAIN = false;
    const float* basef; const bf16_t* baseb; bf16_t* out; int ldc; float sc; const float* rowscale;
    __device__ __forceinline__ void operator()(const f32x4 (&acc)[2][2][4][2], const Unit& u, int wr, int wc, int fr, int fq, PG8_LAS unsigned char* lds) const {
        const int row0 = u.pm * BM + wr * 64 + fr, col0 = u.pn * BM + wc * 32 + 8 * fq;
#pragma unroll
        for (int ai = 0; ai < 2; ++ai)
#pragma unroll
            for (int m = 0; m < 4; ++m) { const size_t off = (size_t)(row0 + ai * HALF + m * 16) * ldc + col0;
                const float s = rowscale ? sc * row_scale(rowscale, u, wr * 64 + fr + ai * HALF + m * 16, lds) : sc;
#pragma unroll
                for (int bj = 0; bj < 2; ++bj) { f32x4 b0, b1;
                    if constexpr (BASE_F32) { b0 = *(const f32x4*)(basef + off + bj * HALF); b1 = *(const f32x4*)(basef + off + bj * HALF + 4); }
                    else { const u32x4 w = *(const u32x4*)(baseb + off + bj * HALF);
                        b0 = (f32x4){__builtin_bit_cast(float, w.x << 16), __builtin_bit_cast(float, w.x & 0xffff0000u), __builtin_bit_cast(float, w.y << 16), __builtin_bit_cast(float, w.y & 0xffff0000u)};
                        b1 = (f32x4){__builtin_bit_cast(float, w.z << 16), __builtin_bit_cast(float, w.z & 0xffff0000u), __builtin_bit_cast(float, w.w << 16), __builtin_bit_cast(float, w.w & 0xffff0000u)}; }
                    const f32x4 v0 = b0 + acc[ai][bj][m][0] * s, v1 = b1 + acc[ai][bj][m][1] * s;
                    u32x4 o; o.x = cvt_pk_bf16(v0[0], v0[1]); o.y = cvt_pk_bf16(v0[2], v0[3]); o.z = cvt_pk_bf16(v1[0], v1[1]); o.w = cvt_pk_bf16(v1[2], v1[3]);
                    *(u32x4*)(out + off + bj * HALF) = o; }
                asm volatile("" ::: "memory"); }
    }
};
struct EpiResF32 {
    static constexpr bool PERM = false, AFTER_DRAIN = false;
    const float* base; float* out; int ldc; float sc; const float* rowscale;
    __device__ __forceinline__ void operator()(const f32x4 (&acc)[2][2][4][2], const Unit& u, int wr, int wc, int fr, int fq, PG8_LAS unsigned char* lds) const {
        const int row0 = u.pm * BM + wr * 64 + fr, col0 = u.pn * BM + wc * 32 + 4 * fq;
#pragma unroll
        for (int ai = 0; ai < 2; ++ai)
#pragma unroll
            for (int m = 0; m < 4; ++m) { const size_t off = (size_t)(row0 + ai * HALF + m * 16) * ldc + col0;
                const float s = rowscale ? sc * row_scale(rowscale, u, wr * 64 + fr + ai * HALF + m * 16, lds) : sc;
#pragma unroll
                for (int bj = 0; bj < 2; ++bj)
#pragma unroll
                    for (int n = 0; n < 2; ++n) { const f32x4 bs = *(const f32x4*)(base + off + bj * HALF + n * 16); *(f32x4*)(out + off + bj * HALF + n * 16) = bs + acc[ai][bj][m][n] * s; }
                asm volatile("" ::: "memory"); }
    }
};

template <class Epi, class Sched, bool ALIGN_EPI = false, bool SP2 = false, int QM = 0>
__device__ __forceinline__ void gemm_phase(PG8_LAS unsigned char* lds, const Gemm g, const Sched& S, const Epi& E, const int tid) {
    constexpr bool F8 = (QM == 1), I8 = (QM == 2);
    const int wid = __builtin_amdgcn_readfirstlane(tid >> 6), lane = tid & 63, wr = wid >> 2, wc = wid & 3, fr = lane & 15, fq = lane >> 4;
    const int K = g.K, nt = K / BK;
    unsigned voffA[2], voffB[2];
#pragma unroll
    for (int i = 0; i < 2; ++i) { int R, C; stage_rc(tid * 16 + i * 8192, R, C); const int Rb = Epi::PERM ? ((R & ~31) + perm32(R & 31)) : R;
        voffA[i] = (unsigned)(R * K + C) * 2u; voffB[i] = (unsigned)(Rb * K + C) * 2u; }
    const size_t kstep = (size_t)(BK * 2);
    const size_t hstep = (size_t)HALF * K * 2;
    const size_t tstep = 2 * hstep;
    const unsigned ldsw = (unsigned)wid * 1024u;
    const int aoff = F8 ? lds_byte(wr * 64 + fr, (fq & 1) * 16) + (fq >> 1) * 1024 : lds_byte(wr * 64 + fr, fq * 8), boff = F8 ? lds_byte(wc * 32 + fr, (fq & 1) * 16) + (fq >> 1) * 1024 : lds_byte(wc * 32 + fr, fq * 8);
#define PG8_SA(b, h) (((b) * 2 + (h)) * HTB)
#define PG8_SB(b, h) ((4 + (b) * 2 + (h)) * HTB)
#define PG8_STAGE(bufoff, gbase, voff) do { _Pragma("unroll") for (int _i = 0; _i < 2; ++_i) \
        __builtin_amdgcn_global_load_lds((const __attribute__((address_space(1))) unsigned*)((const __attribute__((address_space(1))) char*)(gbase) + (voff)[_i]), (PG8_LAS unsigned*)(lds + (bufoff) + ldsw + _i * 8192), 16, 0, 0); } while (0)
#define PG8_LDA(dst, b, h) do { _Pragma("unroll") for (int m = 0; m < 4; ++m) { if constexpr (F8) dst##8[m] = cat8(*(const PG8_LAS bf16x8*)(lds + PG8_SA(b, h) + aoff + m * 2048), *(const PG8_LAS bf16x8*)(lds + PG8_SA(b, h) + aoff + m * 2048 + 16)); \
        else { _Pragma("unroll") for (int k = 0; k < 2; ++k) dst[m][k] = *(const PG8_LAS bf16x8*)(lds + PG8_SA(b, h) + aoff + m * 2048 + k * 1024); } } } while (0)
#define PG8_LDB(dst, b, h) do { _Pragma("unroll") for (int n = 0; n < 2; ++n) { if constexpr (F8) dst##8[n] = cat8(*(const PG8_LAS bf16x8*)(lds + PG8_SB(b, h) + boff + n * 2048), *(const PG8_LAS bf16x8*)(lds + PG8_SB(b, h) + boff + n * 2048 + 16)); \
        else { _Pragma("unroll") for (int k = 0; k < 2; ++k) dst[n][k] = *(const PG8_LAS bf16x8*)(lds + PG8_SB(b, h) + boff + n * 2048 + k * 1024); } } } while (0)
#define PG8_MMA(ai, bj, At, Bt) do { __builtin_amdgcn_s_setprio(1); _Pragma("unroll") for (int m = 0; m < 4; ++m) _Pragma("unroll") for (int n = 0; n < 2; ++n) { \
        if constexpr (F8) acc[ai][bj][m][n] = __builtin_amdgcn_mfma_scale_f32_16x16x128_f8f6f4(Bt##8[n], At##8[m], acc[ai][bj][m][n], 0, 0, 0, 0x7f7f7f7f, 0, 0x7f7f7f7f); \
        else if constexpr (I8) { _Pragma("unroll") for (int k = 0; k < 2; ++k) acc[ai][bj][m][n] = __builtin_bit_cast(f32x4, __builtin_amdgcn_mfma_i32_16x16x64_i8(__builtin_bit_cast(v4i, Bt[n][k]), __builtin_bit_cast(v4i, At[m][k]), __builtin_bit_cast(v4i, acc[ai][bj][m][n]), 0, 0, 0)); } \
        else { _Pragma("unroll") for (int k = 0; k < 2; ++k) acc[ai][bj][m][n] = __builtin_amdgcn_mfma_f32_16x16x32_bf16(Bt[n][k], At[m][k], acc[ai][bj][m][n], 0, 0, 0); } } __builtin_amdgcn_s_setprio(0); } while (0)
#define PG8_WAIT_V(n) asm volatile("s_waitcnt vmcnt(" #n ")" ::: "memory")
#define PG8_WAIT_L(n) asm volatile("s_waitcnt lgkmcnt(" #n ")" ::: "memory")
#define PG8_BAR __builtin_amdgcn_s_barrier()
#define PG8_SCHED __builtin_amdgcn_sched_barrier(0)
    Unit cur, nxt; int ui = 0;
    if (!S.next(0, cur)) return;
    cur.ui = 0; cur.ar = S.arow0(cur);
    if (E.rowscale) {
        Unit tu;
        for (int i = tid >> 8; i < RS_CAP && S.next(i, tu); i += 2)
            *(PG8_LAS unsigned short*)(lds + RS_LDS_OFF + (i * 256 + (tid & 255)) * 2) = (unsigned short)(__builtin_bit_cast(unsigned, E.rowscale[S.arow0(tu) + (tid & 255)]) >> 16);
        asm volatile("s_waitcnt vmcnt(0) lgkmcnt(0)" ::: "memory"); __builtin_amdgcn_s_barrier(); asm volatile("" ::: "memory");
    }
    f32x4 acc[2][2][4][2];
#pragma unroll
    for (int a = 0; a < 2; ++a)
#pragma unroll
        for (int b = 0; b < 2; ++b)
#pragma unroll
            for (int m = 0; m < 4; ++m)
#pragma unroll
                for (int n = 0; n < 2; ++n) acc[a][b][m][n] = (f32x4){0.f, 0.f, 0.f, 0.f};
    bf16x8 At[4][2], B0[2][2], B1[2][2]; v8i At8[4], B08[2], B18[2];
    const char* cA = S.a_ptr(g, cur, tstep); const char* cB = S.b_ptr(g, cur, tstep);
    S.a_ready(cur);
    if constexpr (SP2) {
        PG8_STAGE(PG8_SB(0, 0), cB, voffB); PG8_STAGE(PG8_SB(0, 1), cB + hstep, voffB); PG8_STAGE(PG8_SA(0, 0), cA, voffA); PG8_STAGE(PG8_SA(0, 1), cA + hstep, voffA);
        if (wr == 1) PG8_BAR;
        PG8_WAIT_V(2); PG8_BAR;
        PG8_STAGE(PG8_SB(1, 0), cB + kstep, voffB); PG8_STAGE(PG8_SA(1, 0), cA + kstep, voffA); PG8_STAGE(PG8_SB(1, 1), cB + hstep + kstep, voffB);
        PG8_WAIT_V(6); PG8_BAR;
    } else {
        PG8_STAGE(PG8_SB(0, 0), cB, voffB); PG8_STAGE(PG8_SA(0, 0), cA, voffA); PG8_STAGE(PG8_SB(0, 1), cB + hstep, voffB); PG8_STAGE(PG8_SA(0, 1), cA + hstep, voffA);
        if (wr == 1) PG8_BAR;
        PG8_WAIT_V(4); PG8_BAR;
        PG8_STAGE(PG8_SB(1, 0), cB + kstep, voffB); PG8_STAGE(PG8_SA(1, 0), cA + kstep, voffA); PG8_STAGE(PG8_SB(1, 1), cB + hstep + kstep, voffB);
        PG8_WAIT_V(6); PG8_BAR;
    }
    for (;;) {
        const bool has_next = S.next(ui + 1, nxt);
        const char* nA = has_next ? S.a_ptr(g, nxt, tstep) : cA; const char* nB = has_next ? S.b_ptr(g, nxt, tstep) : cB;
        for (int t = 0; t < nt; t += 2) {
            const bool last = (t == nt - 2);
            const char* a1 = cA + (size_t)(t + 1) * kstep;
            const char* a2 = last ? nA : cA + (size_t)(t + 2) * kstep; const char* b2 = last ? nB : cB + (size_t)(t + 2) * kstep;
            const char* a3 = a2 + kstep; const char* b3 = b2 + kstep;
            const char* a1h = a1 + hstep; const char* a2h = a2 + hstep; const char* b2h = b2 + hstep; const char* b3h = b3 + hstep;
            asm volatile("" : "+v"(voffA[0]), "+v"(voffA[1]), "+v"(voffB[0]), "+v"(voffB[1]));
            asm volatile("" : "+s"(a1h), "+s"(a2), "+s"(a2h), "+s"(a3), "+s"(b2), "+s"(b2h), "+s"(b3), "+s"(b3h));
            if (last && has_next) S.a_ready(nxt);
            if constexpr (SP2) {
            PG8_LDB(B0, 0, 0); PG8_LDB(B1, 0, 1); PG8_SCHED; PG8_LDA(At, 0, 0); PG8_STAGE(PG8_SA(1, 1), a1h, voffA);
            PG8_WAIT_V(8); PG8_WAIT_L(0); PG8_BAR; PG8_MMA(0, 0, At, B0); PG8_MMA(0, 1, At, B1); PG8_BAR; PG8_SCHED;
            PG8_LDA(At, 0, 1); PG8_STAGE(PG8_SB(0, 0), b2, voffB); PG8_STAGE(PG8_SB(0, 1), b2h, voffB); PG8_STAGE(PG8_SA(0, 0), a2, voffA);
            PG8_WAIT_V(8); PG8_WAIT_L(0); PG8_BAR; PG8_MMA(1, 0, At, B0); PG8_MMA(1, 1, At, B1); PG8_BAR; PG8_SCHED;
            PG8_LDB(B0, 1, 0); PG8_LDB(B1, 1, 1); PG8_SCHED; PG8_LDA(At, 1, 0); PG8_STAGE(PG8_SA(0, 1), a2h, voffA);
            PG8_WAIT_V(8); PG8_WAIT_L(0); PG8_BAR; PG8_MMA(0, 0, At, B0); PG8_MMA(0, 1, At, B1); PG8_BAR; PG8_SCHED;
            PG8_LDA(At, 1, 1); PG8_STAGE(PG8_SB(1, 0), b3, voffB); PG8_STAGE(PG8_SB(1, 1), b3h, voffB); PG8_STAGE(PG8_SA(1, 0), a3, voffA);
            PG8_WAIT_V(8); PG8_WAIT_L(0); PG8_BAR; PG8_MMA(1, 0, At, B0); PG8_MMA(1, 1, At, B1); PG8_BAR; PG8_SCHED;
            } else {
            PG8_LDB(B0, 0, 0); PG8_SCHED; PG8_LDA(At, 0, 0); PG8_STAGE(PG8_SA(1, 1), a1h, voffA);
            PG8_WAIT_L(8); PG8_BAR; PG8_WAIT_L(0); PG8_MMA(0, 0, At, B0); PG8_BAR; PG8_SCHED;
            PG8_LDB(B1, 0, 1); PG8_STAGE(PG8_SB(0, 0), b2, voffB);
            PG8_BAR; PG8_WAIT_L(0); PG8_MMA(0, 1, At, B1); PG8_BAR;
            PG8_LDA(At, 0, 1); PG8_STAGE(PG8_SA(0, 0), a2, voffA);
            PG8_BAR; PG8_WAIT_L(0); PG8_MMA(1, 0, At, B0); PG8_BAR; PG8_SCHED;
            PG8_STAGE(PG8_SB(0, 1), b2h, voffB);
            PG8_WAIT_V(6); PG8_BAR; PG8_MMA(1, 1, At, B1); PG8_BAR;
            PG8_LDB(B0, 1, 0); PG8_SCHED; PG8_LDA(At, 1, 0); PG8_STAGE(PG8_SA(0, 1), a2h, voffA);
            PG8_WAIT_L(8); PG8_BAR; PG8_WAIT_L(0); PG8_MMA(0, 0, At, B0); PG8_BAR; PG8_SCHED;
            PG8_LDB(B1, 1, 1); PG8_STAGE(PG8_SB(1, 0), b3, voffB);
            PG8_BAR; PG8_WAIT_L(0); PG8_MMA(0, 1, At, B1); PG8_BAR;
            PG8_LDA(At, 1, 1); PG8_STAGE(PG8_SA(1, 0), a3, voffA);
            PG8_BAR; PG8_WAIT_L(0); PG8_MMA(1, 0, At, B0); PG8_BAR; PG8_SCHED;
            PG8_STAGE(PG8_SB(1, 1), b3h, voffB);
            PG8_WAIT_V(6); PG8_BAR; PG8_MMA(1, 1, At, B1); PG8_BAR;
            }
        }
        if constexpr (ALIGN_EPI) { if (wr == 0) PG8_BAR; }
        if constexpr (I8) {
#pragma unroll
            for (int a = 0; a < 2; ++a)
#pragma unroll
                for (int b = 0; b < 2; ++b)
#pragma unroll
                    for (int m = 0; m < 4; ++m)
#pragma unroll
                        for (int n = 0; n < 2; ++n) { const v4i iv = __builtin_bit_cast(v4i, acc[a][b][m][n]); acc[a][b][m][n] = (f32x4){(float)iv[0], (float)iv[1], (float)iv[2], (float)iv[3]}; } }
        if constexpr (!Epi::AFTER_DRAIN) { E(acc, cur, wr, wc, fr, fq, lds); S.done(cur); }
        if (!has_next) break;
#pragma unroll
        for (int a = 0; a < 2; ++a)
#pragma unroll
            for (int b = 0; b < 2; ++b)
#pragma unroll
                for (int m = 0; m < 4; ++m)
#pragma unroll
                    for (int n = 0; n < 2; ++n) acc[a][b][m][n] = (f32x4){0.f, 0.f, 0.f, 0.f};
        cur = nxt; cA = nA; cB = nB; ++ui; cur.ui = ui; cur.ar = S.arow0(cur);
        if constexpr (ALIGN_EPI) { if (wr == 1) PG8_BAR; }
    }
    PG8_WAIT_V(0);
    if constexpr (!ALIGN_EPI) { if (wr == 0) PG8_BAR; }
    PG8_BAR;
    if constexpr (Epi::AFTER_DRAIN) { E.fused(acc, cur, wr, wc, fr, fq, lds, wid, lane); S.done(cur); }
#undef PG8_SA
#undef PG8_SB
#undef PG8_STAGE
#undef PG8_LDA
#undef PG8_LDB
#undef PG8_MMA
#undef PG8_WAIT_V
#undef PG8_WAIT_L
#undef PG8_BAR
#undef PG8_SCHED
}
}

constexpr int T = 16384, D = 2048, SEQ = 4096, NBATCH = 4, NH = 16, HD = 128;
constexpr int N_IN = 10240, FFN = 5504, NGU = 2 * FFN, NQKV = 3 * D, NE = 8, FE = 7168, NMGU = 2 * FE;
constexpr int FFNP = 5632;
constexpr int P_MAX = 2 * T + NE * 256;
constexpr float EPS = 1e-6f;
constexpr int NWAVES = 8, NTHREADS = 512;

constexpr size_t MiB = 1u << 20;
constexpr size_t WS_CTL = 0, CTL_ZERO_BYTES = 1 * MiB;
constexpr size_t WS_W_IN  = 1 * MiB;
constexpr size_t WS_W_HO  = WS_W_IN  + (size_t)N_IN * D * 2;
constexpr size_t WS_W_GU  = WS_W_HO  + (size_t)D * D * 2;
constexpr size_t WS_W_DN  = WS_W_GU  + (size_t)NGU * D * 2;
constexpr size_t WS_W_QKV = WS_W_DN  + (size_t)D * FFN * 2;
constexpr size_t WS_W_AO  = WS_W_QKV + (size_t)NQKV * D * 2;
constexpr size_t WS_W_MGU = WS_W_AO  + (size_t)D * D * 2;
constexpr size_t WS_W_MDN = WS_W_MGU + (size_t)NE * NMGU * D;
constexpr size_t WS_ARENA = WS_W_MDN + (size_t)NE * D * FE;
constexpr size_t A_HN   = WS_ARENA;
constexpr size_t A_BIG  = A_HN + (size_t)T * D * 2;
constexpr size_t A_OF   = A_BIG + (size_t)T * N_IN * 2;
constexpr size_t A_LSE  = A_OF + (size_t)3 * T * D * 2;
constexpr size_t A_OB   = A_LSE + (size_t)3 * T * NH * 4;
constexpr size_t A_XG   = A_BIG;
constexpr size_t A_MH   = A_XG + (size_t)NE * T * D;
static_assert((size_t)NE * T * D >= (size_t)P_MAX * D * 2, "y fits in the xg region");
constexpr size_t A_MH_OLD_UNUSED = 0;
constexpr size_t A_REC  = (A_MH + (size_t)P_MAX * FE > A_OB + (size_t)T * D * 2) ? A_MH + (size_t)P_MAX * FE : A_OB + (size_t)T * D * 2;
constexpr float Q_W2048 = 127.f / (4.f * 0.022097087f), Q_W7168 = 127.f / (4.f * 0.011811350f), Q_HID = 127.f / 8.f, Q_W5504 = 127.f / (4.f * 0.013479011f);

constexpr size_t A_TSLOT = A_REC + (size_t)T * 32;
constexpr size_t WS_END = A_TSLOT + (size_t)T * 8;
constexpr size_t A_RSTOK = A_TSLOT + (size_t)T * 8;
constexpr size_t A_RSSLOT = A_RSTOK + (size_t)T * 4;
constexpr size_t WS_END2 = A_RSSLOT + (size_t)NE * T * 4;
constexpr size_t A_XR = (WS_END2 + 255) & ~(size_t)255;
constexpr size_t WS_END3 = A_XR + (size_t)T * D * 2;
static_assert(WS_END2 < (size_t)1750 * MiB, "workspace map too large");
static_assert(WS_END < (size_t)1750 * MiB, "workspace map too large");
constexpr int CW_BAR = 4096;
constexpr int CW_MOE = 2048;
constexpr int N_PHASES = 19;

constexpr int RING_BYTES = 131072;
constexpr int LDS_BYTES = 147456;
constexpr int MISC_OFF = LDS_BYTES - 128;

#define GAS __attribute__((address_space(1)))
#define LAS __attribute__((address_space(3)))
typedef unsigned short bf16;
typedef unsigned v4u __attribute__((ext_vector_type(4)));
typedef unsigned v2u __attribute__((ext_vector_type(2)));
typedef float f32x4 __attribute__((ext_vector_type(4)));
typedef float f32x2 __attribute__((ext_vector_type(2)));
typedef short bf16x8 __attribute__((ext_vector_type(8)));
#define RLX_AGENT __ATOMIC_RELAXED, __HIP_MEMORY_SCOPE_AGENT
#define LDS_WAIT() asm volatile("s_waitcnt lgkmcnt(0)" ::: "memory")
__device__ __forceinline__ unsigned f2bf(float f) { unsigned u = __builtin_bit_cast(unsigned, f); return (u + 0x7fffu + ((u >> 16) & 1u)) >> 16; }
typedef float f32x2c __attribute__((ext_vector_type(2))); typedef __bf16 bf16x2c __attribute__((ext_vector_type(2)));
__device__ __forceinline__ unsigned pk2(float lo, float hi) { f32x2c v; v.x = lo; v.y = hi; return __builtin_bit_cast(unsigned, __builtin_convertvector(v, bf16x2c)); }
__device__ __forceinline__ float bflo(unsigned w) { return __builtin_bit_cast(float, w << 16); }
__device__ __forceinline__ float bfhi(unsigned w) { return __builtin_bit_cast(float, w & 0xffff0000u); }
__device__ __forceinline__ float bf2f(bf16 h) { return __builtin_bit_cast(float, (unsigned)h << 16); }

#define XB_TMO      128
#define XB_XCNT(j)  (256  + 64 * (j))
#define XB_XSUB(j)  (1280 + 64 * (j))
#define XB_XGEN(j)  (2304 + 64 * (j))
#define XB_TOP      3328
#define XB_TOPGEN   3392
#define XCD_BAR_WORDS 3456
#define XB_SPIN_CAP (1u << 18)
__device__ __forceinline__ unsigned xb_ld(unsigned* p)              { return __hip_atomic_load(p, __ATOMIC_RELAXED, __HIP_MEMORY_SCOPE_AGENT); }
__device__ __forceinline__ unsigned xb_add(unsigned* p, unsigned v) { return __hip_atomic_fetch_add(p, v, __ATOMIC_RELAXED, __HIP_MEMORY_SCOPE_AGENT); }
__device__ __forceinline__ unsigned xb_xcc_id() { return (unsigned)__builtin_amdgcn_s_getreg((3 << 11) | 20) & 0xFu; }
#define XB_SPIN(cond, bar) do { unsigned _sp = 0; while (cond) { __builtin_amdgcn_s_sleep(1); \
    if ((++_sp & 255u) == 0u) { if (xb_ld(&(bar)[XB_TMO])) break; if (_sp > XB_SPIN_CAP) { atomicAdd(&(bar)[XB_TMO], 1u); break; } } } } while (0)
struct XcdBarrier { unsigned* bar; unsigned x; volatile LAS unsigned* st; };
__device__ __forceinline__ XcdBarrier xcd_barrier_post(unsigned* bar, volatile LAS unsigned* st) {
    XcdBarrier b; b.bar = bar; b.x = xb_xcc_id(); b.st = st;
    if (threadIdx.x == 0) (void)xb_add(&bar[XB_XCNT(b.x)], 1u);
    return b;
}
__device__ __forceinline__ void xcd_barrier_complete(unsigned* bar, unsigned x, unsigned& nloc, unsigned& nx) {
    const unsigned G = gridDim.x * gridDim.y * gridDim.z;
    unsigned sum, cnt, mine, sp = 0u;
    for (;;) {
        sum = 0u; cnt = 0u; mine = 0u;
#pragma unroll
        for (unsigned j = 0; j < 16; ++j) { const unsigned c = xb_ld(&bar[XB_XCNT(j)]); sum += c; cnt += (c > 0u) ? 1u : 0u; mine = (j == x) ? c : mine; }
        if (sum == G) break;
        __builtin_amdgcn_s_sleep(1);
        if ((++sp & 255u) == 0u) { if (xb_ld(&bar[XB_TMO])) break; if (sp > XB_SPIN_CAP) { atomicAdd(&bar[XB_TMO], 1u); break; } }
    }
    nloc = mine > 0u ? mine : 1u; nx = cnt > 0u ? cnt : 1u;
}
__device__ __forceinline__ void xcd_barrier(const XcdBarrier& b, const bool leader  ) {
    asm volatile("s_waitcnt vmcnt(0)" ::: "memory");
    __syncthreads();
    if (leader) {
        unsigned* bar = b.bar;
        __builtin_amdgcn_s_waitcnt(0);
        unsigned nloc = b.st[0], nx = b.st[1];
        if (nloc == 0u) { xcd_barrier_complete(bar, b.x, nloc, nx); b.st[0] = nloc; b.st[1] = nx; }
        const unsigned old = xb_add(&bar[XB_XSUB(b.x)], 1u);
        const unsigned gen = old / nloc;
        if (old + 1u == (gen + 1u) * nloc) {
            __builtin_amdgcn_fence(__ATOMIC_RELEASE, "agent");
            asm volatile("s_waitcnt vmcnt(0)" ::: "memory");
            const unsigned og = xb_add(&bar[XB_TOP], 1u);
            const unsigned tg = og / nx;
            if (og + 1u == (tg + 1u) * nx) xb_add(&bar[XB_TOPGEN], 1u);
            else XB_SPIN(xb_ld(&bar[XB_TOPGEN]) == tg, bar);
            __builtin_amdgcn_fence(__ATOMIC_ACQUIRE, "agent");
            xb_add(&bar[XB_XGEN(b.x)], 1u);
            asm volatile("s_waitcnt vmcnt(0)" ::: "memory");
        } else {
            XB_SPIN(xb_ld(&bar[XB_XGEN(b.x)]) == gen, bar);
            __builtin_amdgcn_fence(__ATOMIC_ACQUIRE, "agent");
            asm volatile("s_waitcnt vmcnt(0)" ::: "memory");
        }
    }
    __syncthreads();
}

struct Args { const float* in[17]; float* out; unsigned char* ws; int ph_lo, ph_hi; };
#define KARG ((const __attribute__((address_space(4))) Args*)__builtin_amdgcn_kernarg_segment_ptr())
struct Frame {
    LAS unsigned char* lds;
    unsigned* ctl;
    int tid, lane, wave, vcu, G;
    unsigned char* ws;
};
__device__ __forceinline__ int lane_id() { int l; asm volatile("v_mbcnt_lo_u32_b32 %0, -1, 0\n\tv_mbcnt_hi_u32_b32 %0, -1, %0" : "=v"(l)); return l; }
#define REFRESH(F) do { (F).lane = lane_id(); (F).tid = (F).wave * 64 + (F).lane; } while (0)
__device__ __forceinline__ float wave_sum(float v) {
#pragma unroll
    for (int o = 1; o < 64; o <<= 1) v += __shfl_xor(v, o);
    return v;
}

struct ConvItem { const float* W; unsigned char* WT; int K, N, ldk, mode, sub; float sc; };
__device__ __forceinline__ void cv_issue(const ConvItem& c, int lane, f32x4 (&ld)[8]) {
    const int nblk = c.N / 32, kb = c.sub / nblk, nb = c.sub % nblk, k0 = 64 * kb, n0 = 32 * nb, kq = lane & 7, nq = lane >> 3;
    const GAS float* src = (const GAS float*)c.W + (size_t)(k0 + 8 * kq) * c.N + n0 + 4 * nq;
#pragma unroll
    for (int i = 0; i < 8; ++i) ld[i] = *(const GAS f32x4*)(src + (size_t)i * c.N);
}
__device__ __forceinline__ void cv_finish_q8(const ConvItem& c, int lane, const f32x4 (&ld)[8]) {
    const int nblk = c.N / 32, kb = c.sub / nblk, nb = c.sub % nblk, k0 = 64 * kb, n0 = 32 * nb, kq = lane & 7, nq = lane >> 3;
    const int nn = n0 + 4 * nq, dq = nn & 127;
    const int orow0 = c.mode == 0 ? nn : c.mode == 3 ? (nn < 2 * D ? (nn & ~127) + 32 * ((dq & 63) >> 4) + 8 * ((dq >> 2) & 3) + 4 * (dq >> 6) : nn)
                                     : (((nn >> 7) << 8) + (c.mode == 2 ? 128 : 0) + (nn & 127));
    const float sc = c.sc;
    unsigned char* dst = c.WT + (size_t)orow0 * c.ldk + k0 + 8 * kq;
#pragma unroll
    for (int j = 0; j < 4; ++j) { v2u o; o.x = pg8::pk4_i8(ld[0][j] * sc, ld[1][j] * sc, ld[2][j] * sc, ld[3][j] * sc); o.y = pg8::pk4_i8(ld[4][j] * sc, ld[5][j] * sc, ld[6][j] * sc, ld[7][j] * sc);
        *(GAS v2u*)(dst + (size_t)j * c.ldk) = o; }
}
__device__ __forceinline__ void cv_finish_bf16(const ConvItem& c, int lane, const f32x4 (&ld)[8]) {
    const int nblk = c.N / 32, kb = c.sub / nblk, nb = c.sub % nblk, k0 = 64 * kb, n0 = 32 * nb, kq = lane & 7, nq = lane >> 3;
    const int nn = n0 + 4 * nq, orow0 = c.mode == 0 ? nn : (((nn >> 7) << 8) + (c.mode == 2 ? 128 : 0) + (nn & 127));
    bf16* dst = (bf16*)c.WT + (size_t)orow0 * c.ldk + k0 + 8 * kq;
#pragma unroll
    for (int j = 0; j < 4; ++j) { v4u o; o.x = pk2(ld[0][j], ld[1][j]); o.y = pk2(ld[2][j], ld[3][j]); o.z = pk2(ld[4][j], ld[5][j]); o.w = pk2(ld[6][j], ld[7][j]);
        *(GAS v4u*)(dst + (size_t)j * c.ldk) = o; }
}
__device__ __forceinline__ void cv128_issue(const ConvItem& c, int lane, f32x4 (&ld)[16]) {
    const int nblk = c.N / 32, kb = c.sub / nblk, nb = c.sub % nblk, k0 = 128 * kb, n0 = 32 * nb, kq = lane & 7, nq = lane >> 3;
    const GAS float* src = (const GAS float*)c.W + (size_t)(k0 + 16 * kq) * c.N + n0 + 4 * nq;
#pragma unroll
    for (int i = 0; i < 16; ++i) ld[i] = __builtin_nontemporal_load((const GAS f32x4*)(src + (size_t)i * c.N));
}
__device__ __forceinline__ void cv128_finish_q8(const ConvItem& c, int lane, const f32x4 (&ld)[16]) {
    const int nblk = c.N / 32, kb = c.sub / nblk, nb = c.sub % nblk, k0 = 128 * kb, n0 = 32 * nb, kq = lane & 7, nq = lane >> 3;
    const int nn = n0 + 4 * nq, orow0 = c.mode == 0 ? nn : (((nn >> 7) << 8) + (c.mode == 2 ? 128 : 0) + (nn & 127));
    const float sc = c.sc;
    unsigned char* dst = c.WT + (size_t)orow0 * c.ldk + k0 + 16 * kq;
#pragma unroll
    for (int j = 0; j < 4; ++j) { v4u o; o.x = pg8::pk4_i8(ld[0][j] * sc, ld[1][j] * sc, ld[2][j] * sc, ld[3][j] * sc); o.y = pg8::pk4_i8(ld[4][j] * sc, ld[5][j] * sc, ld[6][j] * sc, ld[7][j] * sc);
        o.z = pg8::pk4_i8(ld[8][j] * sc, ld[9][j] * sc, ld[10][j] * sc, ld[11][j] * sc); o.w = pg8::pk4_i8(ld[12][j] * sc, ld[13][j] * sc, ld[14][j] * sc, ld[15][j] * sc);
        __builtin_nontemporal_store(o, (GAS v4u*)(dst + (size_t)j * c.ldk)); }
}
__device__ __forceinline__ void p0_transpose_item(const float* W, int K, int N, bf16* WT, int item, int lane, int mode) {
    ConvItem c; c.W = W; c.WT = (unsigned char*)WT; c.K = K; c.N = N; c.ldk = K; c.mode = mode; c.sub = item; c.sc = 1.f;
    f32x4 ld[8]; cv_issue(c, lane, ld); cv_finish_bf16(c, lane, ld);
}
__device__ __forceinline__ void p0_transpose_item_q8(const float* W, int K, int N, unsigned char* WT, int ldk, int item, int lane, int mode, float sc) {
    ConvItem c; c.W = W; c.WT = WT; c.K = K; c.N = N; c.ldk = ldk; c.mode = mode; c.sub = item; c.sc = sc;
    f32x4 ld[8]; cv_issue(c, lane, ld); cv_finish_q8(c, lane, ld);
}
__device__ __forceinline__ void rms_row_to_bf16(const float* xrow, const float* gain, bf16* orow, int lane) {
    const GAS f32x4* xr = (const GAS f32x4*)xrow + lane; const GAS f32x4* gr = (const GAS f32x4*)gain + lane;
    f32x4 v[8]; float s = 0.f;
#pragma unroll
    for (int j = 0; j < 8; ++j) { v[j] = xr[64 * j]; s += (v[j].x * v[j].x + v[j].y * v[j].y) + (v[j].z * v[j].z + v[j].w * v[j].w); }
    const float r = 1.0f / sqrtf(wave_sum(s) * (1.f / D) + EPS);
    GAS v2u* o8 = (GAS v2u*)orow + lane;
#pragma unroll
    for (int j = 0; j < 8; ++j) { const f32x4 g = gr[64 * j]; v2u w; w.x = pk2(v[j].x * r * g.x, v[j].y * r * g.y); w.y = pk2(v[j].z * r * g.z, v[j].w * r * g.w); o8[64 * j] = w; }
}
__device__ __forceinline__ void rms_phase(Frame& F, const float* x, const float* gain, bf16* hn) {
    const int gw = F.vcu * NWAVES + F.wave, NGW = F.G * NWAVES;
    for (int m = gw; m < T; m += NGW) rms_row_to_bf16(x + (size_t)m * D, gain, hn + (size_t)m * D, F.lane);
}
__device__ __forceinline__ void rms_row_to_q8(const float* xrow, const float* gain, unsigned char* orow, float* rs, int lane) {
    const GAS f32x4* xr = (const GAS f32x4*)xrow + lane; const GAS f32x4* gr = (const GAS f32x4*)gain + lane;
    f32x4 v[8]; float s = 0.f, amax = 0.f;
#pragma unroll
    for (int j = 0; j < 8; ++j) { v[j] = xr[64 * j]; s += (v[j].x * v[j].x + v[j].y * v[j].y) + (v[j].z * v[j].z + v[j].w * v[j].w); const f32x4 g = gr[64 * j]; v[j] = v[j] * g;
        amax = fmaxf(amax, fmaxf(fmaxf(fabsf(v[j].x), fabsf(v[j].y)), fmaxf(fabsf(v[j].z), fabsf(v[j].w)))); }
    const float r = 1.0f / sqrtf(wave_sum(s) * (1.f / D) + EPS);
#pragma unroll
    for (int o = 1; o < 64; o <<= 1) amax = fmaxf(amax, __shfl_xor(amax, o));
    amax = fmaxf(amax * r, 1e-20f);
    const float rsv = __builtin_bit_cast(float, (__builtin_bit_cast(unsigned, amax * (1.0f / 127.0f)) + 0xFFFFu) & 0xFFFF0000u);
    const float qs = r / rsv;
    if (lane == 0) *rs = rsv;
    GAS unsigned* o4 = (GAS unsigned*)orow + lane;
#pragma unroll
    for (int j = 0; j < 8; ++j) o4[64 * j] = pg8::pk4_i8(v[j].x * qs, v[j].y * qs, v[j].z * qs, v[j].w * qs);
}
__device__ __forceinline__ f32x4 ld_bf4(const bf16* p) { const v2u w = *(const GAS v2u*)p; return (f32x4){bflo(w.x), bfhi(w.x), bflo(w.y), bfhi(w.y)}; }
__device__ __forceinline__ void rms_row_to_q8_b(const bf16* xrow, const float* gain, unsigned char* orow, float* rs, int lane) {
    const GAS f32x4* gr = (const GAS f32x4*)gain + lane;
    f32x4 v[8]; float s = 0.f, amax = 0.f;
#pragma unroll
    for (int j = 0; j < 8; ++j) v[j] = ld_bf4(xrow + 4 * (lane + 64 * j));
#pragma unroll
    for (int j = 0; j < 8; ++j) { s += (v[j].x * v[j].x + v[j].y * v[j].y) + (v[j].z * v[j].z + v[j].w * v[j].w); const f32x4 g = gr[64 * j]; v[j] = v[j] * g;
        amax = fmaxf(amax, fmaxf(fmaxf(fabsf(v[j].x), fabsf(v[j].y)), fmaxf(fabsf(v[j].z), fabsf(v[j].w)))); }
    const float r = 1.0f / sqrtf(wave_sum(s) * (1.f / D) + EPS);
#pragma unroll
    for (int o = 1; o < 64; o <<= 1) amax = fmaxf(amax, __shfl_xor(amax, o));
    amax = fmaxf(amax * r, 1e-20f);
    const float rsv = __builtin_bit_cast(float, (__builtin_bit_cast(unsigned, amax * (1.0f / 127.0f)) + 0xFFFFu) & 0xFFFF0000u);
    const float qs = r / rsv;
    if (lane == 0) *rs = rsv;
    GAS unsigned* o4 = (GAS unsigned*)orow + lane;
#pragma unroll
    for (int j = 0; j < 8; ++j) o4[64 * j] = pg8::pk4_i8(v[j].x * qs, v[j].y * qs, v[j].z * qs, v[j].w * qs);
}
__device__ __forceinline__ void rms_phase_q8_b(Frame& F, const float* gain) {
    const int gw = F.vcu * NWAVES + F.wave, NGW = F.G * NWAVES;
    for (int m = gw; m < T; m += NGW) rms_row_to_q8_b((const bf16*)(F.ws + A_XR) + (size_t)m * D, gain, F.ws + A_HN + (size_t)m * D, (float*)(F.ws + A_RSTOK) + m, F.lane);
}
__device__ __forceinline__ void rms_phase_q8(Frame& F, const float* x, const float* gain) {
    const int gw = F.vcu * NWAVES + F.wave, NGW = F.G * NWAVES;
    for (int m = gw; m < T; m += NGW) rms_row_to_q8(x + (size_t)m * D, gain, F.ws + A_HN + (size_t)m * D, (float*)(F.ws + A_RSTOK) + m, F.lane);
}
constexpr int MOE_I = (D / 64) * (FE / 32), MOE_NITEMS = 3 * NE * MOE_I;
static_assert(MOE_I == (FE / 64) * (D / 32), "gate/up and down matrices have the same item count");
__device__ __forceinline__ ConvItem moe_item(Frame& F, int r) {
    ConvItem c; const int t = r / (NE * MOE_I), rr = r - t * (NE * MOE_I), e = rr / MOE_I; c.sub = rr - e * MOE_I;
    if (t < 2) { c.W = (t == 0 ? KARG->in[14] : KARG->in[15]) + (size_t)e * D * FE; c.K = D; c.N = FE; c.WT = F.ws + WS_W_MGU + (size_t)e * NMGU * D; c.ldk = D; c.mode = 1 + t; c.sc = Q_W2048; }
    else { c.W = KARG->in[16] + (size_t)e * FE * D; c.K = FE; c.N = D; c.WT = F.ws + WS_W_MDN + (size_t)e * D * FE; c.ldk = FE; c.mode = 0; c.sc = Q_W7168; }
    return c;
}
constexpr int ATT_NPAIR = 64 * 3 * 64 / 2;
#ifndef MK_ATT_CONV
#define MK_ATT_CONV 0
#endif
__device__ __forceinline__ int moe_split(int G) { if (!MK_ATT_CONV) return 0; const long n = (long)((ATT_NPAIR / G) * 3) * (G * NWAVES); return n < MOE_NITEMS ? (int)n : MOE_NITEMS; }
constexpr int MOE_I128 = MOE_I / 2, MOE_N128 = 3 * NE * MOE_I128;
#define MOE128(c_, r_) do { const int t = (r_) / (NE * MOE_I128), rr = (r_) - t * (NE * MOE_I128), e = rr / MOE_I128; c_.sub = rr - e * MOE_I128; \
            if (t < 2) { c_.W = (t == 0 ? KARG->in[14] : KARG->in[15]) + (size_t)e * D * FE; c_.K = D; c_.N = FE; c_.WT = F.ws + WS_W_MGU + (size_t)e * NMGU * D; c_.ldk = D; c_.mode = 1 + t; c_.sc = Q_W2048; } \
            else { c_.W = KARG->in[16] + (size_t)e * FE * D; c_.K = FE; c_.N = D; c_.WT = F.ws + WS_W_MDN + (size_t)e * D * FE; c_.ldk = FE; c_.mode = 0; c_.sc = Q_W7168; } } while (0)
__device__ __forceinline__ void p0_prologue(Frame& F) {
    const int gw = F.vcu * NWAVES + F.wave, NGW = F.G * NWAVES;
    constexpr int I_IN = (D / 64) * (N_IN / 32), I_SQ = (D / 64) * (D / 32), I_G = (D / 64) * (FFN / 32), I_DN = (FFN / 64) * (D / 32), I_QKV = (D / 64) * (NQKV / 32);
    constexpr int NITEMS = I_IN + 2 * I_SQ + 2 * I_G + I_DN + I_QKV + MOE_NITEMS;
    for (int it = gw; it < NITEMS; it += NGW) {
        int r = it;
        if (r < I_IN) { p0_transpose_item_q8((KARG->in[2]), D, N_IN, (F.ws + WS_W_IN), D, r, F.lane, 0, Q_W2048); continue; } r -= I_IN;
        if (MK_ATT_CONV) { const int rm = r + moe_split(F.G); if (rm < MOE_NITEMS) { const ConvItem c = moe_item(F, rm); f32x4 ld[8]; cv_issue(c, F.lane, ld); cv_finish_q8(c, F.lane, ld); } }
        else break;
    }
    { const int gt = (F.vcu * NWAVES + F.wave) * 64 + F.lane, NT = F.G * NWAVES * 64;
      for (int i = gt; i < D * ((FFNP - FFN) / 16); i += NT) { const int n = i / ((FFNP - FFN) / 16), j = i % ((FFNP - FFN) / 16); *(GAS v4u*)(F.ws + WS_W_DN + (size_t)n * FFNP + FFN + j * 16) = (v4u){0u, 0u, 0u, 0u}; }
    }
    { const int gt = (F.vcu * NWAVES + F.wave) * 64 + F.lane, NT = F.G * NWAVES * 64;
      for (int i = gt; i < 256 * D / 16; i += NT) *(GAS v4u*)(F.ws + WS_W_GU + (size_t)NGU * D + (size_t)i * 16) = (v4u){0u, 0u, 0u, 0u};
    }
    rms_phase_q8(F, (KARG->in[0]), (KARG->in[1]));
}

constexpr int SC_QP = 272, SC_VP = 144;
constexpr int SC_QS = 0, SC_KS = 17408, SC_VS = 34816, SC_AT = 44032, SC_EG = 53248, SC_SL = 53760, SC_TOT = 71168, SC_END = 75264;
static_assert(SC_KS == 64 * SC_QP && SC_VS == SC_KS + 64 * SC_QP && SC_AT == SC_VS + 64 * SC_VP && SC_EG == SC_AT + 64 * SC_VP && SC_SL == SC_EG + 512 && SC_TOT == SC_SL + 64 * SC_QP && SC_END == SC_TOT + 4096, "scan LDS map");
static_assert(4 * SC_QP == 1088 && 32 * SC_QP == 8704 && 4 * SC_VP == 576 && 32 * SC_VP == 4608, "immediates in the transposed-read asm");
constexpr int RA_HO = (D / 64) * (D / 32), RA_G = (D / 64) * (FFN / 32), RA_DN = (FFN / 64) * (D / 32), RA_QKV = (D / 64) * (NQKV / 32), RA_AO = (D / 64) * (D / 32);
constexpr int RA_N = RA_HO + 2 * RA_G + RA_DN + RA_QKV + RA_AO;
__device__ __forceinline__ ConvItem ra_item(Frame& F, int r, bool& bf) {
    ConvItem c; c.mode = 0; c.sc = Q_W2048; c.K = D; c.ldk = D; bf = false;
    if (r < RA_HO) { c.W = KARG->in[5]; c.N = D; c.WT = F.ws + WS_W_HO; c.sub = r; c.sc = 1.f; bf = true; return c; } r -= RA_HO;
    if (r < RA_G) { c.W = KARG->in[10]; c.N = FFN; c.WT = F.ws + WS_W_GU; c.sub = r; c.mode = 1; return c; } r -= RA_G;
    if (r < RA_G) { c.W = KARG->in[11]; c.N = FFN; c.WT = F.ws + WS_W_GU; c.sub = r; c.mode = 2; return c; } r -= RA_G;
    if (r < RA_DN) { c.W = KARG->in[12]; c.K = FFN; c.N = D; c.WT = F.ws + WS_W_DN; c.ldk = FFNP; c.sub = r; c.sc = Q_W5504; return c; } r -= RA_DN;
    if (r < RA_QKV) { c.W = KARG->in[6]; c.N = NQKV; c.WT = F.ws + WS_W_QKV; c.sub = r; c.mode = 3; return c; } r -= RA_QKV;
    c.W = KARG->in[9]; c.N = D; c.WT = F.ws + WS_W_AO; c.sub = r; return c;
}
__device__ __forceinline__ void scan_phase(Frame& F) {
    LAS unsigned char* lds = F.lds;
    const unsigned ldsb = (unsigned)(size_t)lds;
    const int tid = F.tid, lane = F.lane, w = F.wave, l15 = lane & 15, g = lane >> 4;
    const int kp = tid & 63, rq = tid >> 6, vr = tid >> 3, vc = tid & 7;
    const unsigned q4 = (unsigned)l15 >> 2, p4 = (unsigned)lane & 3u;
    const int vt = w & 3, ip = w >> 2;
    const bf16* proj = ((bf16*)(F.ws + A_BIG));
    const int ra_base = F.vcu * NWAVES + w, ra_nw = F.G * NWAVES;
    f32x4 cld[8];
#pragma unroll
    for (int i = 0; i < 8; ++i) cld[i] = (f32x4){0.f, 0.f, 0.f, 0.f};
    for (int unit = blockIdx.x; unit < 256; unit += F.G) {
        const int half = unit & 1, dir = (unit >> 1) & 1, h = (unit >> 2) & 15, b = unit >> 6;
        float lbk0, lbk1;
        { const int col = h * 128 + 2 * kp;
          const f32x2 l0 = *(const f32x2*)((KARG->in[3]) + (0 * 2 + dir) * 2048 + col), l1 = *(const f32x2*)((KARG->in[3]) + (1 * 2 + dir) * 2048 + col), l2 = *(const f32x2*)((KARG->in[3]) + (2 * 2 + dir) * 2048 + col);
          { const float mx = fmaxf(l0.x, fmaxf(l1.x, l2.x)); const float e0 = expf(l0.x - mx), e1 = expf(l1.x - mx), e2 = expf(l2.x - mx); lbk0 = e0 / (e0 + e1 + e2); }
          { const float mx = fmaxf(l0.y, fmaxf(l1.y, l2.y)); const float e0 = expf(l0.y - mx), e1 = expf(l1.y - mx), e2 = expf(l2.y - mx); lbk1 = e0 / (e0 + e1 + e2); } }
        const bf16* pb = proj + (size_t)(b * SEQ) * N_IN;
        const int qcol = h * 128 + 2 * kp, fcol = 2048 * (1 + dir) + h * 128 + 2 * kp, vcol = 6144 + h * 128 + half * 64 + vc * 8;
        bf16* obase = ((bf16*)(F.ws + A_OF)) + (size_t)dir * T * D + (size_t)(b * SEQ) * D + h * 128 + half * 64;
        for (int i = tid; i < (64 * SC_VP) / 16; i += NTHREADS) *(LAS v4u*)(lds + SC_AT + i * 16) = (v4u){0u, 0u, 0u, 0u};
        for (int i = tid; i < (64 * SC_QP) / 16; i += NTHREADS) *(LAS v4u*)(lds + SC_SL + i * 16) = (v4u){0u, 0u, 0u, 0u};
        f32x4 S[4];
#pragma unroll
        for (int i = 0; i < 4; ++i) S[i] = (f32x4){0.f, 0.f, 0.f, 0.f};
        unsigned rawq[8], rawf[8]; v4u rawv, vcur;
        float qs0[8], qs1[8], kk0[8], kk1[8], cc0[8], cc1[8];
#define SCAN_TOK(c, tt) (dir ? (SEQ - 1 - ((c) * 64 + (tt))) : ((c) * 64 + (tt)))
#define SC2_LOAD(c) do { _Pragma("unroll") for (int i = 0; i < 8; ++i) { const size_t ro = (size_t)SCAN_TOK(c, 8 * rq + i) * N_IN; rawq[i] = *(const GAS unsigned*)(pb + ro + qcol); rawf[i] = *(const GAS unsigned*)(pb + ro + fcol); } \
        rawv = *(const GAS v4u*)(pb + (size_t)SCAN_TOK(c, vr) * N_IN + vcol); } while (0)
#define SC2_B0A() do { float run0 = 1.f, run1 = 1.f; _Pragma("unroll") for (int i = 0; i < 8; ++i) { \
            const float f0 = lbk0 + (1.0f - lbk0) * bflo(rawf[i]), f1 = lbk1 + (1.0f - lbk1) * bfhi(rawf[i]); kk0[i] = 1.0f - f0; kk1[i] = 1.0f - f1; \
            run0 *= f0; run1 *= f1; cc0[i] = run0; cc1[i] = run1; qs0[i] = bflo(rawq[i]); qs1[i] = bfhi(rawq[i]); } \
        { f32x2 rr; rr.x = run0; rr.y = run1; *(LAS f32x2*)(lds + SC_TOT + (rq * 128 + 2 * kp) * 4) = rr; } vcur = rawv; } while (0)
#define SC2_B0B() do { float base0 = 1.f, base1 = 1.f; _Pragma("unroll") for (int r = 0; r < 7; ++r) { const f32x2 tv = *(const LAS f32x2*)(lds + SC_TOT + (r * 128 + 2 * kp) * 4); if (r < rq) { base0 *= tv.x; base1 *= tv.y; } } \
        _Pragma("unroll") for (int i = 0; i < 8; ++i) { const float eg0 = base0 * cc0[i], eg1 = base1 * cc1[i]; \
            const float ek0 = __builtin_amdgcn_rcpf(fmaxf(eg0, 1.8e-35f)), ek1 = __builtin_amdgcn_rcpf(fmaxf(eg1, 1.8e-35f));        \
            *(LAS unsigned*)(lds + SC_QS + (8 * rq + i) * SC_QP + kp * 4) = pg8::cvt_pk_bf16(qs0[i] * eg0, qs1[i] * eg1); \
            *(LAS unsigned*)(lds + SC_KS + (8 * rq + i) * SC_QP + kp * 4) = pg8::cvt_pk_bf16(kk0[i] * ek0, kk1[i] * ek1); } \
        if (rq == 7) { f32x2 ev; ev.x = base0 * cc0[7]; ev.y = base1 * cc1[7]; *(LAS f32x2*)(lds + SC_EG + 2 * kp * 4) = ev; } \
        *(LAS v4u*)(lds + SC_VS + vr * SC_VP + vc * 16) = vcur; } while (0)
        SC2_LOAD(0);
        SC2_B0A();
        SC2_LOAD(1);
        __syncthreads();
        SC2_B0B();
        for (int c = 0; c < 64; ++c) {
            __syncthreads();
            for (int ti = w; ti < 10; ti += 8) {
                int J, I; if (ti < 4) { J = ti; I = ti; } else if (ti < 7) { J = ti - 4; I = J + 1; } else if (ti < 9) { J = ti - 7; I = J + 2; } else { J = 0; I = 3; }
                f32x4 acc = (f32x4){0.f, 0.f, 0.f, 0.f};
#pragma unroll
                for (int s4 = 0; s4 < 4; ++s4) { const bf16x8 kf = *(const LAS bf16x8*)(lds + SC_KS + (16 * J + l15) * SC_QP + (32 * s4 + 8 * g) * 2);
                    const bf16x8 qf = *(const LAS bf16x8*)(lds + SC_QS + (16 * I + l15) * SC_QP + (32 * s4 + 8 * g) * 2);
                    acc = __builtin_amdgcn_mfma_f32_16x16x32_bf16(kf, qf, acc, 0, 0, 0); }
                if (J == I) {
#pragma unroll
                    for (int e = 0; e < 4; ++e) if (4 * g + e > l15) acc[e] = 0.f; }
                v2u wv; wv.x = pk2(acc[0], acc[1]); wv.y = pk2(acc[2], acc[3]);
                *(LAS v2u*)(lds + SC_AT + (16 * I + l15) * SC_VP + (16 * J + 4 * g) * 2) = wv;
            }
            f32x4 U[4];
            {
                const unsigned ka = ldsb + SC_KS + (8u * g + q4) * SC_QP + (16u * w + 4u * p4) * 2u;
                const unsigned va = ldsb + SC_VS + (8u * g + q4) * SC_VP + p4 * 8u;
                v2u kr[4], vv[16];
                asm volatile(
                    "ds_read_b64_tr_b16 %0, %20 offset:0\n\tds_read_b64_tr_b16 %1, %20 offset:1088\n\tds_read_b64_tr_b16 %2, %20 offset:8704\n\tds_read_b64_tr_b16 %3, %20 offset:9792\n\t"
                    "ds_read_b64_tr_b16 %4, %21 offset:0\n\tds_read_b64_tr_b16 %5, %21 offset:576\n\tds_read_b64_tr_b16 %6, %21 offset:4608\n\tds_read_b64_tr_b16 %7, %21 offset:5184\n\t"
                    "ds_read_b64_tr_b16 %8, %21 offset:32\n\tds_read_b64_tr_b16 %9, %21 offset:608\n\tds_read_b64_tr_b16 %10, %21 offset:4640\n\tds_read_b64_tr_b16 %11, %21 offset:5216\n\t"
                    "ds_read_b64_tr_b16 %12, %21 offset:64\n\tds_read_b64_tr_b16 %13, %21 offset:640\n\tds_read_b64_tr_b16 %14, %21 offset:4672\n\tds_read_b64_tr_b16 %15, %21 offset:5248\n\t"
                    "ds_read_b64_tr_b16 %16, %21 offset:96\n\tds_read_b64_tr_b16 %17, %21 offset:672\n\tds_read_b64_tr_b16 %18, %21 offset:4704\n\tds_read_b64_tr_b16 %19, %21 offset:5280\n\t"
                    "s_waitcnt lgkmcnt(0)"
                    : "=&v"(kr[0]), "=&v"(kr[1]), "=&v"(kr[2]), "=&v"(kr[3]),
                      "=&v"(vv[0]), "=&v"(vv[1]), "=&v"(vv[2]), "=&v"(vv[3]), "=&v"(vv[4]), "=&v"(vv[5]), "=&v"(vv[6]), "=&v"(vv[7]),
                      "=&v"(vv[8]), "=&v"(vv[9]), "=&v"(vv[10]), "=&v"(vv[11]), "=&v"(vv[12]), "=&v"(vv[13]), "=&v"(vv[14]), "=&v"(vv[15])
                    : "v"(ka), "v"(va) : "memory");
#pragma unroll
                for (int j = 0; j < 4; ++j) U[j] = (f32x4){0.f, 0.f, 0.f, 0.f};
#pragma unroll
                for (int ks = 0; ks < 2; ++ks) { union { bf16x8 v; unsigned u[4]; } kf; kf.u[0] = kr[2 * ks].x; kf.u[1] = kr[2 * ks].y; kf.u[2] = kr[2 * ks + 1].x; kf.u[3] = kr[2 * ks + 1].y;
#pragma unroll
                    for (int j = 0; j < 4; ++j) { union { bf16x8 v; unsigned u[4]; } vf; vf.u[0] = vv[4 * j + 2 * ks].x; vf.u[1] = vv[4 * j + 2 * ks].y; vf.u[2] = vv[4 * j + 2 * ks + 1].x; vf.u[3] = vv[4 * j + 2 * ks + 1].y;
                        U[j] = __builtin_amdgcn_mfma_f32_16x16x32_bf16(kf.v, vf.v, U[j], 0, 0, 0); } }
            }
            f32x4 oacc[2];
            oacc[0] = (f32x4){0.f, 0.f, 0.f, 0.f}; oacc[1] = (f32x4){0.f, 0.f, 0.f, 0.f};
#pragma unroll
            for (int s4 = 0; s4 < 4; ++s4) { const bf16x8 sf = *(const LAS bf16x8*)(lds + SC_SL + (16 * vt + l15) * SC_QP + (32 * s4 + 8 * g) * 2);
#pragma unroll
                for (int ii = 0; ii < 2; ++ii) { const bf16x8 qf = *(const LAS bf16x8*)(lds + SC_QS + (16 * (2 * ip + ii) + l15) * SC_QP + (32 * s4 + 8 * g) * 2);
                    oacc[ii] = __builtin_amdgcn_mfma_f32_16x16x32_bf16(sf, qf, oacc[ii], 0, 0, 0); } }
            __syncthreads();
            {
                const unsigned va2 = ldsb + SC_VS + (8u * g + q4) * SC_VP + p4 * 8u + (unsigned)vt * 32u;
                v2u vr4[4];
                asm volatile("ds_read_b64_tr_b16 %0, %4 offset:0\n\tds_read_b64_tr_b16 %1, %4 offset:576\n\tds_read_b64_tr_b16 %2, %4 offset:4608\n\tds_read_b64_tr_b16 %3, %4 offset:5184\n\ts_waitcnt lgkmcnt(0)"
                    : "=&v"(vr4[0]), "=&v"(vr4[1]), "=&v"(vr4[2]), "=&v"(vr4[3]) : "v"(va2) : "memory");
                union { bf16x8 v; unsigned u[4]; } v0, v1; v0.u[0] = vr4[0].x; v0.u[1] = vr4[0].y; v0.u[2] = vr4[1].x; v0.u[3] = vr4[1].y; v1.u[0] = vr4[2].x; v1.u[1] = vr4[2].y; v1.u[2] = vr4[3].x; v1.u[3] = vr4[3].y;
#pragma unroll
                for (int ii = 0; ii < 2; ++ii) { const int I = 2 * ip + ii;
                    const bf16x8 a0 = *(const LAS bf16x8*)(lds + SC_AT + (16 * I + l15) * SC_VP + (8 * g) * 2);
                    oacc[ii] = __builtin_amdgcn_mfma_f32_16x16x32_bf16(v0.v, a0, oacc[ii], 0, 0, 0);
                    if (ip == 1) { const bf16x8 a1 = *(const LAS bf16x8*)(lds + SC_AT + (16 * I + l15) * SC_VP + (32 + 8 * g) * 2);
                        oacc[ii] = __builtin_amdgcn_mfma_f32_16x16x32_bf16(v1.v, a1, oacc[ii], 0, 0, 0); }
                    v2u wv; wv.x = pk2(oacc[ii][0], oacc[ii][1]); wv.y = pk2(oacc[ii][2], oacc[ii][3]);
                    *(GAS v2u*)(obase + (size_t)SCAN_TOK(c, 16 * I + l15) * D + 16 * vt + 4 * g) = wv; }
            }
            { const f32x4 eg = *(const LAS f32x4*)(lds + SC_EG + (16 * w + 4 * g) * 4);
#pragma unroll
              for (int j = 0; j < 4; ++j) { S[j] = eg * (S[j] + U[j]);
                  v2u wv; wv.x = pk2(S[j][0], S[j][1]); wv.y = pk2(S[j][2], S[j][3]);
                  *(LAS v2u*)(lds + SC_SL + (16 * j + l15) * SC_QP + (16 * w + 4 * g) * 2) = wv; } }
            SC2_B0A();
            __syncthreads();
            if (c + 1 < 64) SC2_B0B();
            __builtin_amdgcn_sched_barrier(0);
            { const int cl = c + 2 < 64 ? c + 2 : 63; SC2_LOAD(cl); }
            if ((c & 3) == 1) { const int r = ra_base + (c >> 2) * ra_nw; if (r < RA_N) { bool bf; const ConvItem ci = ra_item(F, r, bf); if (bf) cv_finish_bf16(ci, lane, cld); else cv_finish_q8(ci, lane, cld); } }
            if ((c & 3) == 0) { const int r = ra_base + (c >> 2) * ra_nw; if (r < RA_N) { bool bf; const ConvItem ci = ra_item(F, r, bf); cv_issue(ci, lane, cld); } }
        }
        __syncthreads();
#undef SCAN_TOK
#undef SC2_LOAD
#undef SC2_B0A
#undef SC2_B0B
    }
    for (int r = ra_base + 16 * ra_nw; r < RA_N; r += ra_nw) { bool bf; const ConvItem ci = ra_item(F, r, bf); cv_issue(ci, lane, cld); if (bf) cv_finish_bf16(ci, lane, cld); else cv_finish_q8(ci, lane, cld); }
}

__device__ __forceinline__ void onorm_phase(Frame& F) {
    const int gw = F.vcu * NWAVES + F.wave, NGW = F.G * NWAVES, lane = F.lane;
    const bf16* proj = ((bf16*)(F.ws + A_BIG));
    for (int m = gw; m < T; m += NGW) {
        v4u as_[4], bs_[4], gs_[4];
#pragma unroll
        for (int pass = 0; pass < 4; ++pass) { const int c0 = (pass * 64 + lane) * 8;
            as_[pass] = *(const GAS v4u*)(((bf16*)(F.ws + A_OF)) + (size_t)m * D + c0); bs_[pass] = *(const GAS v4u*)(((bf16*)(F.ws + A_OF)) + (size_t)T * D + (size_t)m * D + c0);
            gs_[pass] = *(const GAS v4u*)(proj + (size_t)m * N_IN + 8192 + c0); }
#pragma unroll
        for (int pass = 0; pass < 4; ++pass) {
            const int c0 = (pass * 64 + lane) * 8;
            const v4u a = as_[pass], bq = bs_[pass];
            const v4u gt = gs_[pass];
            const f32x4 g0 = *(const GAS f32x4*)((KARG->in[4]) + c0), g1 = *(const GAS f32x4*)((KARG->in[4]) + c0 + 4);
            const unsigned aw[4] = {a.x, a.y, a.z, a.w}, bw[4] = {bq.x, bq.y, bq.z, bq.w}, gw4[4] = {gt.x, gt.y, gt.z, gt.w};
            const float gn[8] = {g0.x, g0.y, g0.z, g0.w, g1.x, g1.y, g1.z, g1.w};
            float o[8], ss = 0.f;
#pragma unroll
            for (int j = 0; j < 4; ++j) { o[2 * j] = bflo(aw[j]) + bflo(bw[j]); o[2 * j + 1] = bfhi(aw[j]) + bfhi(bw[j]); ss += o[2 * j] * o[2 * j] + o[2 * j + 1] * o[2 * j + 1]; }
            ss += __shfl_xor(ss, 1); ss += __shfl_xor(ss, 2); ss += __shfl_xor(ss, 4); ss += __shfl_xor(ss, 8);
            const float r = 1.0f / sqrtf(ss * (1.f / 128.f) + EPS);
            float y[8];
#pragma unroll
            for (int j = 0; j < 4; ++j) { const float t0 = bflo(gw4[j]), t1 = bfhi(gw4[j]);
                y[2 * j] = o[2 * j] * r * gn[2 * j] * (t0 * __builtin_amdgcn_rcpf(1.0f + __expf(-t0)));
                y[2 * j + 1] = o[2 * j + 1] * r * gn[2 * j + 1] * (t1 * __builtin_amdgcn_rcpf(1.0f + __expf(-t1))); }
            v4u w; w.x = pk2(y[0], y[1]); w.y = pk2(y[2], y[3]); w.z = pk2(y[4], y[5]); w.w = pk2(y[6], y[7]);
            *(GAS v4u*)(((bf16*)(F.ws + A_OB)) + (size_t)m * D + c0) = w;
        }
    }
}

__device__ __forceinline__ void qknorm_rope_phase(Frame& F) {
    const int gw = F.vcu * NWAVES + F.wave, NGW = F.G * NWAVES, lane = F.lane, hs = lane >> 4, i4 = lane & 15;
    bf16* qkv = ((bf16*)(F.ws + A_BIG));
    float inv[4], qg1[4], qg2[4], kg1[4], kg2[4];
#pragma unroll
    for (int e = 0; e < 4; ++e) { inv[e] = expf(-(float)(4 * i4 + e) * (2.0f / 128.0f) * 9.210340371976184f) * 0.15915494309189535f;
        qg1[e] = (KARG->in[7])[4 * i4 + e]; qg2[e] = (KARG->in[7])[64 + 4 * i4 + e]; kg1[e] = (KARG->in[8])[4 * i4 + e]; kg2[e] = (KARG->in[8])[64 + 4 * i4 + e]; }
    for (int m = gw; m < T; m += NGW) {
        const float pos = (float)(m & (SEQ - 1));
        float sn[4], cs[4];
#pragma unroll
        for (int e = 0; e < 4; ++e) { float rev = pos * inv[e]; rev -= floorf(rev); sn[e] = __builtin_amdgcn_sinf(rev); cs[e] = __builtin_amdgcn_cosf(rev); }
        bf16* rowp = qkv + (size_t)m * NQKV + hs * 128 + 4 * i4;
        v2u ras[8], rbs[8];
#pragma unroll
        for (int p = 0; p < 8; ++p) { const bf16* base = rowp + (p < 4 ? 0 : 2048) + (p & 3) * 512; ras[p] = *(const GAS v2u*)base; rbs[p] = *(const GAS v2u*)(base + 64); }
#pragma unroll
        for (int p = 0; p < 8; ++p) {
            const bool isq = p < 4; bf16* base = rowp + (isq ? 0 : 2048) + (p & 3) * 512;
            const v2u ra = ras[p], rb = rbs[p];
            const float x1[4] = {bflo(ra.x), bfhi(ra.x), bflo(ra.y), bfhi(ra.y)}, x2[4] = {bflo(rb.x), bfhi(rb.x), bflo(rb.y), bfhi(rb.y)};
            float ss = (x1[0] * x1[0] + x1[1] * x1[1]) + (x1[2] * x1[2] + x1[3] * x1[3]) + (x2[0] * x2[0] + x2[1] * x2[1]) + (x2[2] * x2[2] + x2[3] * x2[3]);
            ss += __shfl_xor(ss, 1); ss += __shfl_xor(ss, 2); ss += __shfl_xor(ss, 4); ss += __shfl_xor(ss, 8);
            const float r = (1.0f / sqrtf(ss * (1.f / 128.f) + EPS)) * (isq ? 0.12751743075f : 1.0f);
            float o1[4], o2[4];
#pragma unroll
            for (int e = 0; e < 4; ++e) { const float y1 = x1[e] * r * (isq ? qg1[e] : kg1[e]), y2 = x2[e] * r * (isq ? qg2[e] : kg2[e]); o1[e] = y1 * cs[e] - y2 * sn[e]; o2[e] = y2 * cs[e] + y1 * sn[e]; }
            v2u wa, wb; wa.x = pk2(o1[0], o1[1]); wa.y = pk2(o1[2], o1[3]); wb.x = pk2(o2[0], o2[1]); wb.y = pk2(o2[2], o2[3]);
            *(GAS v2u*)base = wa; *(GAS v2u*)(base + 64) = wb;
        }
    }
}

constexpr int ATT_KP = 272;
constexpr int ATT_GRP_BYTES = 2 * 64 * ATT_KP;
template <int V> struct AttIC { static constexpr int value = V; };
__device__ __forceinline__ void attn_phase(Frame& F) {
    const int tid = F.tid, lane = F.lane, w = F.wave, qi = w & 3, gtid = tid & 255;
    const int l15 = lane & 15, g = lane >> 4;
    LAS unsigned char* Kbase = F.lds;
    const bf16* qkv = ((bf16*)(F.ws + A_BIG));
    bf16* obr = ((bf16*)(F.ws + A_OF)); float* lse = ((float*)(F.ws + A_LSE));
    constexpr int NPAIR = ATT_NPAIR;
    const int per = (NPAIR + F.G - 1) / F.G, p_lo = F.vcu * per, p_hi = (p_lo + per < NPAIR) ? p_lo + per : NPAIR;
    const int nit = (p_hi > p_lo) ? (p_hi - p_lo) * 6 : 0;
    v4u R0[8], R1[8]; bf16x8 Qn0[4], Qn1[4], Qh[4];
    int b = 0, h = 0, br = 0, r = 1, n = SEQ, cls = 0, nb = 0;
    bf16x8 Qf[4]; f32x4 Ot[8]; float mrow = -1e29f, lrow = 0.f;
    for (int s4 = 0; s4 < 4; ++s4) { Qn0[s4] = (bf16x8){0, 0, 0, 0, 0, 0, 0, 0}; Qn1[s4] = Qn0[s4]; }
#define ATT_UNIT(it_) do { const int uid = 2 * p_lo + (it_) / 3; const int bh = uid / 192, rem = uid - bh * 192; br = rem >> 6; const int idx = rem & 63; \
        b = bh >> 4; h = bh & 15; r = 1 << (2 * br); n = SEQ >> (2 * br); const int sh = 6 - 2 * br; cls = idx >> sh; nb = idx & ((1 << sh) - 1); } while (0)
#define ATT_PREFETCH(it_, R, Qn) do { int b_, h_, r_, n_, cls_, nb_; { const int uid = 2 * p_lo + (it_) / 3; const int bh = uid / 192, rem = uid - bh * 192; const int br_ = rem >> 6, idx = rem & 63; \
            b_ = bh >> 4; h_ = bh & 15; r_ = 1 << (2 * br_); n_ = SEQ >> (2 * br_); const int sh = 6 - 2 * br_; cls_ = idx >> sh; nb_ = idx & ((1 << sh) - 1); } \
        const int kp0 = 64 * (nb_ - 1 + (it_) % 3), kp0c = kp0 < 0 ? 0 : (kp0 >= n_ ? n_ - 64 : kp0);     \
        const GAS char* kbase = (const GAS char*)qkv + ((size_t)(b_ * SEQ + cls_ + r_ * kp0c) * NQKV + 2048 + h_ * 128) * 2; \
        const GAS char* qbase = (const GAS char*)qkv + ((size_t)(b_ * SEQ + cls_ + r_ * 64 * nb_) * NQKV + h_ * 128) * 2; \
        const unsigned rstride = (unsigned)r_ * (NQKV * 2); \
          \
          \
        { _Pragma("unroll") for (int i = 0; i < 4; ++i) { const unsigned voff = (unsigned)((gtid >> 4) + 16 * i) * rstride + (unsigned)(gtid & 15) * 16u; R[i] = *(const GAS v4u*)(kbase + voff); R[4 + i] = *(const GAS v4u*)(kbase + voff + 4096u); } } \
        { const unsigned voffq = (unsigned)(16 * qi + l15) * rstride + 16u * g; \
            _Pragma("unroll") for (int s4 = 0; s4 < 4; ++s4) Qn[s4] = *(const GAS bf16x8*)(qbase + voffq + 64u * s4); } } while (0)
#pragma unroll
    for (int s4 = 0; s4 < 4; ++s4) Qh[s4] = Qn0[s4];
    __syncthreads();
    if (w >= 4) {
        const int cw = F.vcu * 4 + (w - 4), CN = F.G * 4;
        const int nmine = cw < MOE_N128 ? (MOE_N128 - cw + CN - 1) / CN : 0;
        f32x4 la[16], lb[16], lc[16]; ConvItem ca;
        if (nmine > 0) { MOE128(ca, cw); cv128_issue(ca, lane, la); }
        if (nmine > 1) { MOE128(ca, cw + CN); cv128_issue(ca, lane, lb); }
        if (nmine > 2) { MOE128(ca, cw + 2 * CN); cv128_issue(ca, lane, lc); }
        __builtin_amdgcn_s_barrier();
#define ATT_CSTEP(buf_, j_) do { const int r_ = cw + (j_) * CN; MOE128(ca, r_); cv128_finish_q8(ca, lane, buf_); if ((j_) + 3 < nmine) { MOE128(ca, r_ + 3 * CN); cv128_issue(ca, lane, buf_); } } while (0)
        for (int j = 0; j < nmine; j += 3) {
            ATT_CSTEP(la, j);
            if (j + 1 < nmine) ATT_CSTEP(lb, j + 1);
            if (j + 2 < nmine) ATT_CSTEP(lc, j + 2);
        }
#undef ATT_CSTEP
        return;
    }
    volatile LAS unsigned* aflag = (volatile LAS unsigned*)(F.lds + 4 * ATT_GRP_BYTES);
    if (lane == 0) aflag[qi] = 0u;
    __builtin_amdgcn_s_setprio(3);
    if (nit > 0) {
        ATT_PREFETCH(0, R0, Qn0);
#pragma unroll
        for (int i = 0; i < 4; ++i) { const int idx = gtid + 256 * i, row = idx >> 4, ch = idx & 15; *(LAS v4u*)(Kbase + row * ATT_KP + ch * 16) = R0[i]; *(LAS v4u*)(Kbase + 64 * ATT_KP + row * ATT_KP + ch * 16) = R0[4 + i]; }
#pragma unroll
        for (int s4 = 0; s4 < 4; ++s4) Qh[s4] = Qn0[s4];
        { const int i1 = nit > 1 ? 1 : 0; ATT_PREFETCH(i1, R1, Qn1); }
        { const int i2 = nit > 2 ? 2 : nit - 1; ATT_PREFETCH(i2, R0, Qn0); }
    }
    __syncthreads();
    int sbase = 0;
    auto trip = [&](auto kbc, auto setc, const int it) __attribute__((always_inline)) {
        constexpr int kb = decltype(kbc)::value; constexpr int SET = decltype(setc)::value;
        if (kb == 0) {
            ATT_UNIT(it);
            if (it > 0) sbase += (nb == 0) ? 3 : 1;
#pragma unroll
            for (int s4 = 0; s4 < 4; ++s4) Qf[s4] = Qh[s4];
#pragma unroll
            for (int c = 0; c < 8; ++c) Ot[c] = (f32x4){0.f, 0.f, 0.f, 0.f};
            mrow = -1e29f; lrow = 0.f;
        }
        LAS unsigned char* Kl = Kbase + ((sbase + kb) & 3) * ATT_GRP_BYTES; LAS unsigned char* Vl = Kl + 64 * ATT_KP;
        bool fresh_n; int slot_n;
        if (kb < 2) { slot_n = (sbase + kb + 1) & 3; fresh_n = (kb == 1) || (it < 3) || (nb == 0); }
        else { const int uidn = 2 * p_lo + it / 3 + 1, remn = uidn % 192, shn = 6 - 2 * (remn >> 6), nbn = (remn & 63) & ((1 << shn) - 1);
               const bool fs = (nbn == 0); slot_n = (sbase + (fs ? 3 : 1)) & 3; fresh_n = fs && (it + 1 < nit); }
        LAS unsigned char* Kn = Kbase + slot_n * ATT_GRP_BYTES;
#define ATT_STAGE(R, Qn) do { if (fresh_n) { _Pragma("unroll") for (int i = 0; i < 4; ++i) { const int idx = gtid + 256 * i, row = idx >> 4, ch = idx & 15; *(LAS v4u*)(Kn + row * ATT_KP + ch * 16) = R[i]; *(LAS v4u*)(Kn + 64 * ATT_KP + row * ATT_KP + ch * 16) = R[4 + i]; } } \
            if ((it + 1) % 3 == 0) { _Pragma("unroll") for (int s4 = 0; s4 < 4; ++s4) Qh[s4] = Qn[s4]; } \
            { const int itn = (it + 3 < nit) ? it + 3 : nit - 1; ATT_PREFETCH(itn, R, Qn); } } while (0)
        if constexpr (SET == 0) ATT_STAGE(R0, Qn0); else ATT_STAGE(R1, Qn1);
#undef ATT_STAGE
        const int pq = 64 * nb + 16 * qi + l15, kp0 = 64 * (nb - 1 + kb);
        f32x4 sc[4];
        { const unsigned ka = (unsigned)(size_t)Kl + (unsigned)l15 * ATT_KP + 16u * g;
          static_assert(16 * ATT_KP == 4352, "immediates in the K fragment read asm");
#pragma unroll
          for (int half = 0; half < 2; ++half) {
              bf16x8 kf[8];
              const unsigned kb2 = ka + (unsigned)half * 2u * 4352u;
              asm volatile("ds_read_b128 %0, %8 offset:0\n\tds_read_b128 %1, %8 offset:64\n\tds_read_b128 %2, %8 offset:128\n\tds_read_b128 %3, %8 offset:192\n\t"
                           "ds_read_b128 %4, %8 offset:4352\n\tds_read_b128 %5, %8 offset:4416\n\tds_read_b128 %6, %8 offset:4480\n\tds_read_b128 %7, %8 offset:4544\n\ts_waitcnt lgkmcnt(0)"
                           : "=&v"(kf[0]), "=&v"(kf[1]), "=&v"(kf[2]), "=&v"(kf[3]), "=&v"(kf[4]), "=&v"(kf[5]), "=&v"(kf[6]), "=&v"(kf[7]) : "v"(kb2) : "memory");
#pragma unroll
              for (int k2 = 0; k2 < 2; ++k2) { const int kt = 2 * half + k2; sc[kt] = (f32x4){0.f, 0.f, 0.f, 0.f};
#pragma unroll
                  for (int s4 = 0; s4 < 4; ++s4) sc[kt] = __builtin_amdgcn_mfma_f32_16x16x32_bf16(kf[4 * k2 + s4], Qf[s4], sc[kt], 0, 0, 0); } } }
        const unsigned q4 = (unsigned)l15 >> 2, p4 = (unsigned)lane & 3u;
        const unsigned va = (unsigned)(size_t)Vl + (4u * g + q4) * ATT_KP + p4 * 8u;
        v2u t0[8], t1[8];
#define ATT_VREAD(va_, tail_) asm volatile( \
                "ds_read_b64_tr_b16 %0, %16 offset:0\n\tds_read_b64_tr_b16 %1, %16 offset:32\n\tds_read_b64_tr_b16 %2, %16 offset:64\n\tds_read_b64_tr_b16 %3, %16 offset:96\n\t" \
                "ds_read_b64_tr_b16 %4, %16 offset:128\n\tds_read_b64_tr_b16 %5, %16 offset:160\n\tds_read_b64_tr_b16 %6, %16 offset:192\n\tds_read_b64_tr_b16 %7, %16 offset:224\n\t" \
                "ds_read_b64_tr_b16 %8, %17 offset:0\n\tds_read_b64_tr_b16 %9, %17 offset:32\n\tds_read_b64_tr_b16 %10, %17 offset:64\n\tds_read_b64_tr_b16 %11, %17 offset:96\n\t" \
                "ds_read_b64_tr_b16 %12, %17 offset:128\n\tds_read_b64_tr_b16 %13, %17 offset:160\n\tds_read_b64_tr_b16 %14, %17 offset:192\n\tds_read_b64_tr_b16 %15, %17 offset:224\n\t" \
                tail_ \
                : "=&v"(t0[0]), "=&v"(t0[1]), "=&v"(t0[2]), "=&v"(t0[3]), "=&v"(t0[4]), "=&v"(t0[5]), "=&v"(t0[6]), "=&v"(t0[7]), \
                  "=&v"(t1[0]), "=&v"(t1[1]), "=&v"(t1[2]), "=&v"(t1[3]), "=&v"(t1[4]), "=&v"(t1[5]), "=&v"(t1[6]), "=&v"(t1[7]) \
                : "v"(va_), "v"((va_) + 16u * ATT_KP) : "memory")
        ATT_VREAD(va, "");
        const int qq = 16 * qi + l15; const bool blk_ok = (kp0 >= 0) && (kp0 < n);
        if (kb != 1) {
            const int c0 = qq - 4 * g;
            if (kb == 0) { const int cth = blk_ok ? c0 : 1000;
#pragma unroll
                for (int kt = 0; kt < 4; ++kt)
#pragma unroll
                    for (int e = 0; e < 4; ++e) sc[kt][e] = (16 * kt + e >= cth) ? sc[kt][e] : -1e30f; }
            else { const int cth = blk_ok ? c0 : -1000;
#pragma unroll
                for (int kt = 0; kt < 4; ++kt)
#pragma unroll
                    for (int e = 0; e < 4; ++e) sc[kt][e] = (16 * kt + e <= cth) ? sc[kt][e] : -1e30f; }
        }
        float mx = fmaxf(fmaxf(sc[0][0], sc[0][1]), fmaxf(sc[0][2], sc[0][3]));
#pragma unroll
        for (int kt = 1; kt < 4; ++kt) mx = fmaxf(mx, fmaxf(fmaxf(sc[kt][0], sc[kt][1]), fmaxf(sc[kt][2], sc[kt][3])));
        mx = fmaxf(mx, __shfl_xor(mx, 16)); mx = fmaxf(mx, __shfl_xor(mx, 32));
        const float mnew = fmaxf(mrow, mx), alpha = __builtin_amdgcn_exp2f(mrow - mnew);
        float rs = 0.f; float p[4][4];
#pragma unroll
        for (int kt = 0; kt < 4; ++kt)
#pragma unroll
            for (int e = 0; e < 4; ++e) { p[kt][e] = __builtin_amdgcn_exp2f(sc[kt][e] - mnew); rs += p[kt][e]; }
        rs += __shfl_xor(rs, 16); rs += __shfl_xor(rs, 32);
        lrow = lrow * alpha + rs; mrow = mnew;
#pragma unroll
        for (int c = 0; c < 8; ++c) Ot[c] = Ot[c] * alpha;
        asm volatile("s_waitcnt lgkmcnt(0)"
            : "+v"(t0[0]), "+v"(t0[1]), "+v"(t0[2]), "+v"(t0[3]), "+v"(t0[4]), "+v"(t0[5]), "+v"(t0[6]), "+v"(t0[7]),
              "+v"(t1[0]), "+v"(t1[1]), "+v"(t1[2]), "+v"(t1[3]), "+v"(t1[4]), "+v"(t1[5]), "+v"(t1[6]), "+v"(t1[7]) :: "memory");
#pragma unroll
        for (int ks = 0; ks < 2; ++ks) {
            union { bf16x8 v; unsigned u[4]; } pf;
            pf.u[0] = pg8::cvt_pk_bf16(p[2 * ks][0], p[2 * ks][1]); pf.u[1] = pg8::cvt_pk_bf16(p[2 * ks][2], p[2 * ks][3]); pf.u[2] = pg8::cvt_pk_bf16(p[2 * ks + 1][0], p[2 * ks + 1][1]); pf.u[3] = pg8::cvt_pk_bf16(p[2 * ks + 1][2], p[2 * ks + 1][3]);
            if (ks == 1) { const unsigned va1 = va + 32u * ATT_KP; ATT_VREAD(va1, "s_waitcnt lgkmcnt(0)"); }
#pragma unroll
            for (int c = 0; c < 8; ++c) { union { bf16x8 v; unsigned u[4]; } vf; vf.u[0] = t0[c].x; vf.u[1] = t0[c].y; vf.u[2] = t1[c].x; vf.u[3] = t1[c].y;
                Ot[c] = __builtin_amdgcn_mfma_f32_16x16x32_bf16(vf.v, pf.v, Ot[c], 0, 0, 0); }
        }
        if (kb == 2) {
            const float il = 1.0f / lrow; const size_t mrowi = (size_t)(b * SEQ + cls + r * pq);
            bf16* op = obr + (size_t)br * T * D + mrowi * D + h * 128 + 4 * g;
#pragma unroll
            for (int c = 0; c < 8; ++c) { v2u wv; wv.x = pg8::cvt_pk_bf16(Ot[c][0] * il, Ot[c][1] * il); wv.y = pg8::cvt_pk_bf16(Ot[c][2] * il, Ot[c][3] * il); *(GAS v2u*)(op + 16 * c) = wv; }
            if (g == 0) lse[(size_t)br * T * NH + mrowi * NH + h] = (mrow + __builtin_amdgcn_logf(lrow)) * 0.6931471805599453f;
        }
        asm volatile("s_waitcnt lgkmcnt(0)" ::: "memory");
        if (lane == 0) aflag[qi] = (unsigned)(it + 1);
        for (;;) { const v4u fl = *(volatile LAS v4u*)aflag; const unsigned mn = min(min(fl.x, fl.y), min(fl.z, fl.w)); if (__builtin_amdgcn_readfirstlane(mn) >= (unsigned)(it + 1)) break; }
        asm volatile("" ::: "memory");
        };
    for (int it = 0; it < nit; it += 6) {
        trip(AttIC<0>{}, AttIC<1>{}, it); trip(AttIC<1>{}, AttIC<0>{}, it + 1); trip(AttIC<2>{}, AttIC<1>{}, it + 2);
        trip(AttIC<0>{}, AttIC<0>{}, it + 3); trip(AttIC<1>{}, AttIC<1>{}, it + 4); trip(AttIC<2>{}, AttIC<0>{}, it + 5);
    }
    __builtin_amdgcn_s_setprio(0);
#undef ATT_VREAD
#undef ATT_UNIT
#undef ATT_PREFETCH
}
__device__ __forceinline__ void attn_combine_phase(Frame& F) {
    const int gw = F.vcu * NWAVES + F.wave, NGW = F.G * NWAVES, lane = F.lane;
    for (int m = gw; m < T; m += NGW) {
        float o[4][8]; float amax = 0.f;
#pragma unroll
        for (int pass = 0; pass < 4; ++pass) {
            const int c0 = (pass * 64 + lane) * 8, hh = c0 >> 7;
            const float l0 = ((float*)(F.ws + A_LSE))[(size_t)m * NH + hh], l1 = ((float*)(F.ws + A_LSE))[(size_t)T * NH + (size_t)m * NH + hh], l2 = ((float*)(F.ws + A_LSE))[(size_t)2 * T * NH + (size_t)m * NH + hh];
            const float mx = fmaxf(l0, fmaxf(l1, l2)); const float e0 = __expf(l0 - mx), e1 = __expf(l1 - mx), e2 = __expf(l2 - mx); const float is = 1.0f / (e0 + e1 + e2);
            const float w0 = e0 * is, w1 = e1 * is, w2 = e2 * is;
            const v4u a = *(const GAS v4u*)(((bf16*)(F.ws + A_OF)) + (size_t)m * D + c0), bq = *(const GAS v4u*)(((bf16*)(F.ws + A_OF)) + (size_t)T * D + (size_t)m * D + c0), cq = *(const GAS v4u*)(((bf16*)(F.ws + A_OF)) + (size_t)2 * T * D + (size_t)m * D + c0);
            const unsigned aw[4] = {a.x, a.y, a.z, a.w}, bw[4] = {bq.x, bq.y, bq.z, bq.w}, cw[4] = {cq.x, cq.y, cq.z, cq.w};
#pragma unroll
            for (int j = 0; j < 4; ++j) { o[pass][2 * j] = w0 * bflo(aw[j]) + w1 * bflo(bw[j]) + w2 * bflo(cw[j]); o[pass][2 * j + 1] = w0 * bfhi(aw[j]) + w1 * bfhi(bw[j]) + w2 * bfhi(cw[j]);
                amax = fmaxf(amax, fmaxf(fabsf(o[pass][2 * j]), fabsf(o[pass][2 * j + 1]))); }
        }
#pragma unroll
        for (int x = 1; x < 64; x <<= 1) amax = fmaxf(amax, __shfl_xor(amax, x));
        amax = fmaxf(amax, 1e-20f);
        const float rsv = __builtin_bit_cast(float, (__builtin_bit_cast(unsigned, amax * (1.0f / 127.0f)) + 0xFFFFu) & 0xFFFF0000u);
        const float qs = 1.0f / rsv;
        if (lane == 0) ((float*)(F.ws + A_RSTOK))[m] = rsv;
#pragma unroll
        for (int pass = 0; pass < 4; ++pass) { const int c0 = (pass * 64 + lane) * 8;
            v2u w; w.x = pg8::pk4_i8(o[pass][0] * qs, o[pass][1] * qs, o[pass][2] * qs, o[pass][3] * qs); w.y = pg8::pk4_i8(o[pass][4] * qs, o[pass][5] * qs, o[pass][6] * qs, o[pass][7] * qs);
            *(GAS v2u*)((F.ws + A_OB) + (size_t)m * D + c0) = w; }
    }
}

__device__ __forceinline__ void router_phase(Frame& F) {
    const int tid = F.tid, lane = F.lane, w = F.wave;
    LAS int* sE = (LAS int*)F.lds;
    LAS float* sG = (LAS float*)(F.lds + 512);
    LAS int* lcnt = (LAS int*)(F.lds + 1024);
    LAS int* gbase = (LAS int*)(F.lds + 1088);
    LAS float* LW = (LAS float*)(F.lds + 4096);
    const float* gain = (KARG->in[1]) + 3 * D;
    for (int idx = tid; idx < D * 2; idx += NTHREADS) { const int c = idx >> 1, hf = idx & 1, j = c >> 8, ln = (c & 255) >> 2, q = c & 3;
        *(LAS f32x4*)(LW + ((j * 4 + q) * 64 + ln) * 8 + hf * 4) = *(const GAS f32x4*)((KARG->in[13]) + (size_t)c * NE + hf * 4); }
    __syncthreads();
    for (int blk = blockIdx.x; blk < T / 64; blk += F.G) {
        if (tid < 8) lcnt[tid] = 0;
        f32x4 v[8];
#pragma unroll 1
        for (int i = 0; i < 8; ++i) {
            const int ti = w * 8 + i, m = blk * 64 + ti;
            const GAS f32x4* gr = (const GAS f32x4*)gain + lane;
            { const bf16* xr = (const bf16*)(F.ws + A_XR) + (size_t)m * D;
#pragma unroll
              for (int j = 0; j < 8; ++j) v[j] = ld_bf4(xr + 4 * (lane + 64 * j)); }
            float s = 0.f, amax = 0.f;
#pragma unroll
            for (int j = 0; j < 8; ++j) { s += (v[j].x * v[j].x + v[j].y * v[j].y) + (v[j].z * v[j].z + v[j].w * v[j].w); const f32x4 g = gr[64 * j]; v[j] = v[j] * g;
                amax = fmaxf(amax, fmaxf(fmaxf(fabsf(v[j].x), fabsf(v[j].y)), fmaxf(fabsf(v[j].z), fabsf(v[j].w)))); }
#pragma unroll
            for (int o = 1; o < 64; o <<= 1) { s += __shfl_xor(s, o); amax = fmaxf(amax, __shfl_xor(amax, o)); }
            const float r = 1.0f / sqrtf(s * (1.f / D) + EPS);
            amax = fmaxf(amax * r, 1e-20f);
            const float rsv = __builtin_bit_cast(float, (__builtin_bit_cast(unsigned, amax * (1.0f / 127.0f)) + 0xFFFFu) & 0xFFFF0000u);
            const float qs = 1.0f / rsv;
            if (lane == 0) ((float*)(F.ws + A_RSTOK))[m] = rsv;
            GAS unsigned* o8 = (GAS unsigned*)((F.ws + A_HN) + (size_t)m * D) + lane;
            float lg[8];
#pragma unroll
            for (int e = 0; e < 8; ++e) lg[e] = 0.f;
#pragma unroll
            for (int j = 0; j < 8; ++j) { const float y[4] = {v[j].x * r, v[j].y * r, v[j].z * r, v[j].w * r};
                o8[64 * j] = pg8::pk4_i8(y[0] * qs, y[1] * qs, y[2] * qs, y[3] * qs);
#pragma unroll
                for (int q = 0; q < 4; ++q) { const LAS f32x4* wp = (const LAS f32x4*)(LW + ((j * 4 + q) * 64 + lane) * 8); const f32x4 wa = wp[0], wb = wp[1];
                    lg[0] = fmaf(y[q], wa.x, lg[0]); lg[1] = fmaf(y[q], wa.y, lg[1]); lg[2] = fmaf(y[q], wa.z, lg[2]); lg[3] = fmaf(y[q], wa.w, lg[3]);
                    lg[4] = fmaf(y[q], wb.x, lg[4]); lg[5] = fmaf(y[q], wb.y, lg[5]); lg[6] = fmaf(y[q], wb.z, lg[6]); lg[7] = fmaf(y[q], wb.w, lg[7]); }
                __builtin_amdgcn_sched_barrier(0); }
            float l4[4], l2[2], l1;
#pragma unroll
            for (int q = 0; q < 4; ++q) { const bool hi = (lane & 32) != 0; const float snd = hi ? lg[q] : lg[q + 4], kp = hi ? lg[q + 4] : lg[q]; l4[q] = kp + __shfl_xor(snd, 32); }
#pragma unroll
            for (int q = 0; q < 2; ++q) { const bool hi = (lane & 16) != 0; const float snd = hi ? l4[q] : l4[q + 2], kp = hi ? l4[q + 2] : l4[q]; l2[q] = kp + __shfl_xor(snd, 16); }
            { const bool hi = (lane & 8) != 0; const float snd = hi ? l2[0] : l2[1], kp = hi ? l2[1] : l2[0]; l1 = kp + __shfl_xor(snd, 8); }
            l1 += __shfl_xor(l1, 4); l1 += __shfl_xor(l1, 2); l1 += __shfl_xor(l1, 1);
#pragma unroll
            for (int e = 0; e < 8; ++e) lg[e] = __shfl(l1, ((e >> 2) & 1) * 32 + ((e >> 1) & 1) * 16 + (e & 1) * 8);
            int e0 = 0; float b0 = lg[0];
#pragma unroll
            for (int e = 1; e < 8; ++e) if (lg[e] > b0) { b0 = lg[e]; e0 = e; }
            int e1 = -1; float b1 = -3.0e38f;
#pragma unroll
            for (int e = 0; e < 8; ++e) if (e != e0 && lg[e] > b1) { b1 = lg[e]; e1 = e; }
            const float g1 = 1.0f / (1.0f + __expf(b0 - b1)), g0 = 1.0f - g1;
            if (lane == 0) { sE[2 * ti] = e0; sE[2 * ti + 1] = e1; sG[2 * ti] = g0; sG[2 * ti + 1] = g1; }
        }
        __syncthreads();
        int e0 = 0, e1 = 0, r0 = 0, r1 = 0;
        if (tid < 64) { e0 = sE[2 * tid]; e1 = sE[2 * tid + 1]; r0 = atomicAdd((int*)&lcnt[e0], 1); r1 = atomicAdd((int*)&lcnt[e1], 1); }
        __syncthreads();
        if (tid < 8) gbase[tid] = (int)__hip_atomic_fetch_add(F.ctl + CW_MOE + 64 * tid, (unsigned)lcnt[tid], RLX_AGENT);
        __syncthreads();
        if (tid < 64) { const int m = blk * 64 + tid; int* rc = ((int*)(F.ws + A_REC)) + (size_t)m * 8;
            rc[0] = e0; rc[1] = gbase[e0] + r0; rc[2] = e1; rc[3] = gbase[e1] + r1; rc[4] = __builtin_bit_cast(int, sG[2 * tid]); rc[5] = __builtin_bit_cast(int, sG[2 * tid + 1]);
            sE[2 * tid] = e0 * T + gbase[e0] + r0; sE[2 * tid + 1] = e1 * T + gbase[e1] + r1; }
        asm volatile("s_waitcnt vmcnt(0)" ::: "memory");
        __syncthreads();
#pragma unroll 2
        for (int i = 0; i < 8; ++i) { const int ti = w * 8 + i, m = blk * 64 + ti; const int s0 = sE[2 * ti], s1 = sE[2 * ti + 1];
            const GAS v4u* src = (const GAS v4u*)((F.ws + A_HN) + (size_t)m * D) + lane;
            GAS v4u* d0 = (GAS v4u*)((F.ws + A_XG) + (size_t)s0 * D) + lane; GAS v4u* d1 = (GAS v4u*)((F.ws + A_XG) + (size_t)s1 * D) + lane;
            const v4u va = src[0], vb = src[64]; d0[0] = va; d0[64] = vb; d1[0] = va; d1[64] = vb;
            if (lane == 0) { const float rs = ((float*)(F.ws + A_RSTOK))[m]; ((float*)(F.ws + A_RSSLOT))[s0] = rs; ((float*)(F.ws + A_RSSLOT))[s1] = rs; } }
        __syncthreads();
    }
}
__device__ __forceinline__ void moe_tiles(Frame& F, int (&cnt)[8], int (&ct)[9]) {
    ct[0] = 0;
#pragma unroll
    for (int e = 0; e < 8; ++e) { cnt[e] = __builtin_amdgcn_readfirstlane((int)__hip_atomic_load(F.ctl + CW_MOE + 64 * e, RLX_AGENT)); ct[e + 1] = ct[e] + ((cnt[e] + 255) >> 8); }
}
__device__ __forceinline__ int moe_full_tiles(int ntiles) { return (ntiles / 32) * 32; }
template <int PART> __device__ __forceinline__ void moe_combine_phase(Frame& F) {
    const int lane = F.lane;
    const bf16* y = ((bf16*)(F.ws + A_XG));
    int cnt[8], ct[9]; moe_tiles(F, cnt, ct);
    const int ntA = moe_full_tiles(ct[8]), ntu = (ct[8] - ntA) * (D / 256), ntw = ntu < F.G ? ntu : F.G, nfree = F.G - ntw;
    const int gw = (PART == 1 ? ((int)blockIdx.x - ntw) : F.vcu) * NWAVES + F.wave, NGW = (PART == 1 ? nfree : F.G) * NWAVES;
    if (PART == 1 && (int)blockIdx.x < ntw) return;
    for (int m = gw; m < T; m += NGW) {
        const int* rc = ((int*)(F.ws + A_REC)) + (size_t)m * 8; const int e0 = rc[0], r0 = rc[1], e1 = rc[2], r1 = rc[3];
        int o0 = 0, o1 = 0;
#pragma unroll
        for (int e = 0; e < 8; ++e) { if (e == e0) o0 = ct[e]; if (e == e1) o1 = ct[e]; }
        const bool late = (o0 + (r0 >> 8) >= ntA) || (o1 + (r1 >> 8) >= ntA);
        if (PART == 1 ? late : (!late && nfree > 0)) continue;
        const int s0 = o0 * 256 + r0, s1 = o1 * 256 + r1;
        const float g0 = __builtin_bit_cast(float, ((int*)(F.ws + A_REC))[(size_t)m * 8 + 4]), g1 = __builtin_bit_cast(float, ((int*)(F.ws + A_REC))[(size_t)m * 8 + 5]);
        v4u a4[4], b4[4], xr4[4];
#pragma unroll
        for (int pass = 0; pass < 4; ++pass) { const int c0 = (pass * 64 + lane) * 8;
            a4[pass] = *(const GAS v4u*)(y + (size_t)s0 * D + c0); b4[pass] = *(const GAS v4u*)(y + (size_t)s1 * D + c0);
            xr4[pass] = *(const GAS v4u*)((const bf16*)(F.ws + A_XR) + (size_t)m * D + c0); }
#pragma unroll
        for (int pass = 0; pass < 4; ++pass) {
            const int c0 = (pass * 64 + lane) * 8;
            const v4u a = a4[pass], bq = b4[pass];
            float* op = (KARG->out) + (size_t)m * D + c0; const v4u xw = xr4[pass];
            f32x4 x0 = (f32x4){bflo(xw.x), bfhi(xw.x), bflo(xw.y), bfhi(xw.y)}, x1 = (f32x4){bflo(xw.z), bfhi(xw.z), bflo(xw.w), bfhi(xw.w)};
            x0.x += g0 * bflo(a.x) + g1 * bflo(bq.x); x0.y += g0 * bfhi(a.x) + g1 * bfhi(bq.x); x0.z += g0 * bflo(a.y) + g1 * bflo(bq.y); x0.w += g0 * bfhi(a.y) + g1 * bfhi(bq.y);
            x1.x += g0 * bflo(a.z) + g1 * bflo(bq.z); x1.y += g0 * bfhi(a.z) + g1 * bfhi(bq.z); x1.z += g0 * bflo(a.w) + g1 * bflo(bq.w); x1.w += g0 * bfhi(a.w) + g1 * bfhi(bq.w);
            *(GAS f32x4*)op = x0; *(GAS f32x4*)(op + 4) = x1;
        }
    }
}

#ifndef MK_PER_PHASE
#define MK_PER_PHASE 0
#endif
__global__ void __launch_bounds__(NTHREADS, 2) mk_fwd(Args args) {
    extern __shared__ __attribute__((aligned(16))) unsigned char lds[];
    Frame F;
    F.lds = (LAS unsigned char*)lds;
    F.tid = threadIdx.x; F.lane = F.tid & 63; F.wave = __builtin_amdgcn_readfirstlane(F.tid >> 6);
    F.G = gridDim.x; { const int bx = blockIdx.x; F.vcu = (F.G % 8 == 0) ? (bx % 8) * (F.G / 8) + bx / 8 : bx; }
    F.ws = args.ws; F.ctl = (unsigned*)(args.ws + WS_CTL);
    volatile LAS unsigned* MISC = (volatile LAS unsigned*)(F.lds + MISC_OFF);
    if (F.tid < 32) MISC[F.tid] = 0u;
    __syncthreads();
    const int lo = args.ph_lo, hi = args.ph_hi;
    XcdBarrier bar; bar.bar = F.ctl + CW_BAR; bar.x = 0; bar.st = nullptr;
    if (hi - lo > 1) bar = xcd_barrier_post(F.ctl + CW_BAR, MISC + 8);
#define IN(k) (lo <= (k) && (k) < hi)
#ifndef MK_AMP_MASK
#define MK_AMP_MASK 0u
#endif
    unsigned long long amp_t0 = MK_AMP_MASK ? __builtin_amdgcn_s_memrealtime() : 0ull;
#define SEAM(k) do { if (IN(k) && IN((k) + 1)) xcd_barrier(bar, F.wave == 0 && lane_id() == 0); REFRESH(F); \
        if (MK_AMP_MASK) { const unsigned long long t1_ = __builtin_amdgcn_s_memrealtime(); \
            if ((MK_AMP_MASK >> (k)) & 1u) { const unsigned long long d_ = t1_ - amp_t0; while (__builtin_amdgcn_s_memrealtime() - t1_ < d_) __builtin_amdgcn_s_sleep(8); } \
            amp_t0 = __builtin_amdgcn_s_memrealtime(); } } while (0)
    typedef pg8::StaticOrder SO;
#ifndef MK_STAGGER_TICKS
#define MK_STAGGER_TICKS 0
#endif
#define STAGGER() do { if (MK_STAGGER_TICKS && ((blockIdx.x >> 3) & 1)) { const unsigned long long t0_ = __builtin_amdgcn_s_memrealtime(); while (__builtin_amdgcn_s_memrealtime() - t0_ < (unsigned long long)MK_STAGGER_TICKS) __builtin_amdgcn_s_sleep(8); } } while (0)

    if (IN(0)) { p0_prologue(F); } SEAM(0);
    if (IN(1)) { STAGGER(); pg8::Gemm g{((bf16*)(F.ws + A_HN)), ((bf16*)(F.ws + WS_W_IN)), D / 2}; SO S; S.init(T / 256, N_IN / 256, F.G, (int)blockIdx.x);
        pg8::EpiBf16 E{((bf16*)(F.ws + A_BIG)), N_IN, 1.0f / Q_W2048, (const float*)(F.ws + A_RSTOK), 1};
        pg8::gemm_phase<pg8::EpiBf16, SO, true, true, 2>(F.lds, g, S, E, F.tid); } SEAM(1);
    if (IN(2)) { scan_phase(F); } SEAM(2);
    if (IN(3)) { onorm_phase(F); } SEAM(3);
    if (IN(4)) { pg8::Gemm g{((bf16*)(F.ws + A_OB)), ((bf16*)(F.ws + WS_W_HO)), D}; SO S; S.init(T / 256, D / 256, F.G, (int)blockIdx.x);
        pg8::EpiResB<true> E{(KARG->in[0]), nullptr, (bf16*)(F.ws + A_XR), D, 1.0f, nullptr};
        pg8::gemm_phase<pg8::EpiResB<true>, SO, true, true>(F.lds, g, S, E, F.tid); } SEAM(4);
    if (IN(5)) { rms_phase_q8_b(F, (KARG->in[1]) + D); } SEAM(5);
    if (IN(6)) { pg8::Gemm g{((bf16*)(F.ws + A_HN)), ((bf16*)(F.ws + WS_W_GU)), D / 2}; SO S; S.init(T / 256, NGU / 256, F.G, (int)blockIdx.x);
        pg8::EpiSwigluQ8 E{(F.ws + A_BIG), FFNP, 1.0f / Q_W2048, Q_HID, (float*)(F.ws + A_RSTOK)};
        pg8::gemm_phase<pg8::EpiSwigluQ8, SO, true, true, 2>(F.lds, g, S, E, F.tid); } SEAM(6);
    if (IN(7)) { pg8::Gemm g{((bf16*)(F.ws + A_BIG)), ((bf16*)(F.ws + WS_W_DN)), FFNP / 2}; SO S; S.init(T / 256, D / 256, F.G, (int)blockIdx.x);
        pg8::EpiResB<false> E{nullptr, (const bf16*)(F.ws + A_XR), (bf16*)(F.ws + A_XR), D, 1.0f / (Q_HID * Q_W5504), nullptr};
        pg8::gemm_phase<pg8::EpiResB<false>, SO, true, true, 2>(F.lds, g, S, E, F.tid); } SEAM(7);
    if (IN(8)) { rms_phase_q8_b(F, (KARG->in[1]) + 2 * D); } SEAM(8);
    if (IN(9)) { STAGGER(); pg8::Gemm g{((bf16*)(F.ws + A_HN)), ((bf16*)(F.ws + WS_W_QKV)), D / 2}; SO S; S.init(T / 256, NQKV / 256, F.G, (int)blockIdx.x);
        if (F.tid < 256) *(LAS float*)(F.lds + pg8::QR_G_OFF + F.tid * 4) = F.tid < 128 ? (KARG->in[7])[F.tid] : (KARG->in[8])[F.tid - 128];
        pg8::EpiQkvRope E{((bf16*)(F.ws + A_BIG)), NQKV, 1.0f / Q_W2048, (const float*)(F.ws + A_RSTOK), EPS, 0.12751743075f, SEQ - 1};
        pg8::gemm_phase<pg8::EpiQkvRope, SO, true, true, 2>(F.lds, g, S, E, F.tid); } SEAM(9);
    if (IN(11)) { attn_phase(F); } SEAM(11);
    if (IN(12)) { attn_combine_phase(F); } SEAM(12);
    if (IN(13)) { pg8::Gemm g{((bf16*)(F.ws + A_OB)), ((bf16*)(F.ws + WS_W_AO)), D / 2}; SO S; S.init(T / 256, D / 256, F.G, (int)blockIdx.x);
        pg8::EpiResB<false> E{nullptr, (const bf16*)(F.ws + A_XR), (bf16*)(F.ws + A_XR), D, 1.0f / Q_W2048, (const float*)(F.ws + A_RSTOK)};
        pg8::gemm_phase<pg8::EpiResB<false>, SO, true, true, 2>(F.lds, g, S, E, F.tid); } SEAM(13);
    if (IN(14)) { router_phase(F); } SEAM(14);
    if (IN(15)) { int cnt[8], ct[9]; moe_tiles(F, cnt, ct);
        pg8::Gemm g{((bf16*)(F.ws + A_XG)), (const bf16*)(F.ws + WS_W_MGU), D / 2}; pg8::MoeOrder S; S.init(ct[8], NMGU / 256, F.G, (int)blockIdx.x);
        S.c1 = ct[1]; S.c2 = ct[2]; S.c3 = ct[3]; S.c4 = ct[4]; S.c5 = ct[5]; S.c6 = ct[6]; S.c7 = ct[7]; S.estride = (size_t)NMGU * D; S.avirt = T;
        pg8::EpiSwigluQ8 E{(F.ws + A_MH), FE, 1.0f / Q_W2048, Q_HID, ((float*)(F.ws + A_RSSLOT))};
        pg8::gemm_phase<pg8::EpiSwigluQ8, pg8::MoeOrder, true, true, 2>(F.lds, g, S, E, F.tid); } SEAM(15);
    if (IN(16)) { int cnt[8], ct[9]; moe_tiles(F, cnt, ct);
        pg8::Gemm g{(const bf16*)(F.ws + A_MH), (const bf16*)(F.ws + WS_W_MDN), FE / 2}; pg8::MoeOrder S; S.init(moe_full_tiles(ct[8]), D / 256, F.G, (int)blockIdx.x);
        S.c1 = ct[1]; S.c2 = ct[2]; S.c3 = ct[3]; S.c4 = ct[4]; S.c5 = ct[5]; S.c6 = ct[6]; S.c7 = ct[7]; S.estride = (size_t)D * FE; S.avirt = 0;
        pg8::EpiBf16 E{((bf16*)(F.ws + A_XG)), D, 1.0f / (Q_HID * Q_W7168), nullptr, 0};
        pg8::gemm_phase<pg8::EpiBf16, pg8::MoeOrder, true, true, 2>(F.lds, g, S, E, F.tid); } SEAM(16);
    if (IN(17)) { int cnt[8], ct[9]; moe_tiles(F, cnt, ct);
        const int ntA = moe_full_tiles(ct[8]), ntu = (ct[8] - ntA) * (D / 256);
        if ((int)blockIdx.x < ntu) {
            pg8::Gemm g{(const bf16*)(F.ws + A_MH), (const bf16*)(F.ws + WS_W_MDN), FE / 2}; pg8::MoeTailOrder S; S.init(ct[8], D / 256, F.G, (int)blockIdx.x); S.pm0 = ntA; S.ntu = ntu;
            S.c1 = ct[1]; S.c2 = ct[2]; S.c3 = ct[3]; S.c4 = ct[4]; S.c5 = ct[5]; S.c6 = ct[6]; S.c7 = ct[7]; S.estride = (size_t)D * FE; S.avirt = 0;
            pg8::EpiBf16 E{((bf16*)(F.ws + A_XG)), D, 1.0f / (Q_HID * Q_W7168), nullptr, 0};
            pg8::gemm_phase<pg8::EpiBf16, pg8::MoeTailOrder, true, true, 2>(F.lds, g, S, E, F.tid);
        } else moe_combine_phase<1>(F); } SEAM(17);
    if (IN(18)) { moe_combine_phase<2>(F); }
    if (MK_AMP_MASK & (1u << 18)) { asm volatile("s_waitcnt vmcnt(0)" ::: "memory"); const unsigned long long t1_ = __builtin_amdgcn_s_memrealtime(), d_ = t1_ - amp_t0; while (__builtin_amdgcn_s_memrealtime() - t1_ < d_) __builtin_amdgcn_s_sleep(8); }
#undef IN
#undef SEAM
}

extern "C" void kernel_launch(void* const* d_in, const int* in_sizes, int n_in, void* d_out, int out_size, void* d_ws, size_t ws_size, hipStream_t stream) {
    static int grid = 0;
    if (grid == 0) {
        if (n_in != 17 || out_size != T * D || ws_size < WS_END3) { fprintf(stderr, "kernel_launch: unexpected shapes (n_in %d out %d ws %zu need %zu)\n", n_in, out_size, ws_size, (size_t)WS_END3); grid = -1; return; }
        int dev = 0, cus = 0, per_cu = 0;
        if (hipGetDevice(&dev) != hipSuccess || hipDeviceGetAttribute(&cus, hipDeviceAttributeMultiprocessorCount, dev) != hipSuccess) { grid = -1; return; }
        if (hipFuncSetAttribute((const void*)mk_fwd, hipFuncAttributeMaxDynamicSharedMemorySize, LDS_BYTES) != hipSuccess) { fprintf(stderr, "kernel_launch: hipFuncSetAttribute failed\n"); grid = -1; return; }
        if (hipOccupancyMaxActiveBlocksPerMultiprocessor(&per_cu, (const void*)mk_fwd, NTHREADS, LDS_BYTES) != hipSuccess || per_cu < 1) { fprintf(stderr, "kernel_launch: occupancy query reports %d\n", per_cu); }
        (void)hipGetLastError();
        grid = cus;
    }
    if (grid < 0) return;
    (void)hipMemsetAsync((char*)d_ws + WS_CTL, 0, CTL_ZERO_BYTES, stream);
    Args a{};
    for (int i = 0; i < 17; ++i) a.in[i] = (const float*)d_in[i];
    a.out = (float*)d_out; a.ws = (unsigned char*)d_ws;
#if MK_PER_PHASE
    for (int p = 0; p < N_PHASES; ++p) { a.ph_lo = p; a.ph_hi = p + 1; hipLaunchKernelGGL(mk_fwd, dim3(grid), dim3(NTHREADS), LDS_BYTES, stream, a); }
#else
    a.ph_lo = 0; a.ph_hi = N_PHASES;
    hipLaunchKernelGGL(mk_fwd, dim3(grid), dim3(NTHREADS), LDS_BYTES, stream, a);
#endif
}
```
